# Optimizing an MI355X kernel written in HIP

```python
import math
import jax, jax.numpy as jnp
from jax import lax
import numpy as np

D_MODEL = 1024
BATCH = 8
SEQ = 4096
DEPTH = 2

ATTN_HEADS = 8
ATTN_HEAD_DIM = 64
ATTN_WIDTH = ATTN_HEADS * ATTN_HEAD_DIM
HGRN_HEADS = 4
HGRN_HEAD_DIM = 128
HGRN_WIDTH = HGRN_HEADS * HGRN_HEAD_DIM
MIX_WIDTH = ATTN_WIDTH + HGRN_WIDTH
IN_PROJ_WIDTH = 3 * ATTN_WIDTH + 4 * HGRN_WIDTH
DILATED_PATTERNS = ((128, 1), (512, 4), (2048, 16))
ROPE_THETA = 10000.0
HGRN_CHUNK = 16
MLP_HIDDEN = 4 * D_MODEL
NORM_EPS = 1e-6
MASK_VALUE = -1e30

kernel_name = 'hymba_hgrn2_dilated_swa_hybrid'


def rms_norm(x, gain):
    xf = x.astype(jnp.float32)
    xf = xf * lax.rsqrt(jnp.mean(xf * xf, axis=-1, keepdims=True) + NORM_EPS)
    return (xf * gain.astype(jnp.float32)).astype(x.dtype)


def split_heads(a, n_heads, head_dim):
    b, s, _ = a.shape
    return a.reshape(b, s, n_heads, head_dim).transpose(0, 2, 1, 3)


def merge_heads(a):
    b, h, s, d = a.shape
    return a.transpose(0, 2, 1, 3).reshape(b, s, h * d)


def rotary(x, positions):
    half = x.shape[-1] // 2
    inv_freq = ROPE_THETA ** (-jnp.arange(half, dtype=jnp.float32) / half)
    ang = positions.astype(jnp.float32)[:, None] * inv_freq[None, :]
    cos, sin = jnp.cos(ang), jnp.sin(ang)
    x1, x2 = x[..., :half], x[..., half:]
    return jnp.concatenate([x1 * cos - x2 * sin, x1 * sin + x2 * cos], axis=-1)


def dilated_window_attention(q, k, v, window, dilation):
    b, h, s, d = q.shape
    span = window // dilation
    unit = dilation * span
    s_pad = -(-s // unit) * unit
    pad = ((0, 0), (0, 0), (0, s_pad - s), (0, 0))
    q, k, v = jnp.pad(q, pad), jnp.pad(k, pad), jnp.pad(v, pad)
    n_sub = s_pad // dilation
    n_blk = n_sub // span

    def to_sub(a):
        a = a.reshape(b, h, n_sub, dilation, d).transpose(0, 1, 3, 2, 4)
        return a.reshape(b, h, dilation, n_blk, span, d)

    def with_prev(a):
        prev = jnp.pad(a, ((0, 0), (0, 0), (0, 0), (1, 0), (0, 0), (0, 0)))[:, :, :, :-1]
        return jnp.concatenate([prev, a], axis=4)

    qs = to_sub(q)
    kc, vc = with_prev(to_sub(k)), with_prev(to_sub(v))
    scores = jnp.einsum('bhrnid,bhrnjd->bhrnij', qs, kc)
    i = jnp.arange(span)[:, None]
    j = jnp.arange(2 * span)[None, :]
    dist = span + i - j
    band = (dist >= 0) & (dist <= span)
    blk = jnp.arange(n_blk)[:, None, None]
    valid = band[None] & ((blk > 0) | (j >= span)[None])
    scores = jnp.where(valid, scores, MASK_VALUE)
    m = jnp.max(scores, axis=-1, keepdims=True)
    p = jnp.where(valid, jnp.exp(scores - m), 0.0)
    l = jnp.sum(p, axis=-1, keepdims=True)
    o = jnp.einsum('bhrnij,bhrnjd->bhrnid', p, vc) / l
    lse = (m + jnp.log(l))[..., 0]

    def from_sub(a):
        tail = a.shape[5:]
        a = a.reshape((b, h, dilation, n_sub) + tail)
        a = jnp.moveaxis(a, 2, 3)
        return a.reshape((b, h, s_pad) + tail)[:, :, :s]

    return from_sub(o), from_sub(lse)


def dilated_attention_group(q_a, k_a, v_a, positions):
    q = rotary(split_heads(q_a, ATTN_HEADS, ATTN_HEAD_DIM).astype(jnp.float32), positions)
    q = q * (ATTN_HEAD_DIM ** -0.5)
    k = rotary(split_heads(k_a, ATTN_HEADS, ATTN_HEAD_DIM).astype(jnp.float32), positions)
    v = split_heads(v_a, ATTN_HEADS, ATTN_HEAD_DIM).astype(jnp.float32)
    outs, lses = [], []
    for window, dilation in DILATED_PATTERNS:
        o, lse = dilated_window_attention(q, k, v, window, dilation)
        outs.append(o)
        lses.append(lse)
    weights = jax.nn.softmax(jnp.stack(lses, axis=0), axis=0)
    o = jnp.einsum('pbhs,pbhsd->bhsd', weights, jnp.stack(outs, axis=0))
    return merge_heads(o)


def hgrn_lower_bounds(lb_logits):
    p = jax.nn.softmax(lb_logits.astype(jnp.float32), axis=0)
    return jnp.cumsum(p, axis=0) - p[0]


def hgrn2_chunkwise(q, k, v, log_f):
    b, h, s, kd = q.shape
    vd = v.shape[-1]
    c = HGRN_CHUNK
    n = s // c
    q = q.reshape(b, h, n, c, kd)
    k = k.reshape(b, h, n, c, kd)
    v = v.reshape(b, h, n, c, vd)
    g = jnp.cumsum(log_f.reshape(b, h, n, c, kd), axis=3)
    g_last = g[:, :, :, -1:]
    causal = jnp.tril(jnp.ones((c, c), dtype=bool))[:, :, None]
    diff = g[:, :, :, :, None, :] - g[:, :, :, None, :, :]
    decay = jnp.where(causal, jnp.exp(jnp.where(causal, diff, 0.0)), 0.0)
    a = jnp.einsum('bhnik,bhnjk,bhnijk->bhnij', q, k, decay)
    o_intra = jnp.einsum('bhnij,bhnjv->bhniv', a, v)
    q_in = q * jnp.exp(g)
    k_out = k * jnp.exp(g_last - g)
    chunk_decay = jnp.exp(g_last[:, :, :, 0])

    def step(state, xs):
        q_n, k_n, v_n, dec_n = xs
        o_n = jnp.einsum('bhik,bhkv->bhiv', q_n, state)
        state = dec_n[..., None] * state + jnp.einsum('bhjk,bhjv->bhkv', k_n, v_n)
        return state, o_n

    xs = (jnp.moveaxis(q_in, 2, 0), jnp.moveaxis(k_out, 2, 0),
          jnp.moveaxis(v, 2, 0), jnp.moveaxis(chunk_decay, 2, 0))
    state0 = jnp.zeros((b, h, kd, vd), dtype=jnp.float32)
    _, o_inter = lax.scan(step, state0, xs)
    o = o_intra + jnp.moveaxis(o_inter, 0, 2)
    return o.reshape(b, h, s, vd)


def hgrn2_group(q_h, f_h, i_h, g_h, lower_bound, out_gain):
    q = jax.nn.silu(split_heads(q_h, HGRN_HEADS, HGRN_HEAD_DIM).astype(jnp.float32))
    q = q * (HGRN_HEAD_DIM ** -0.5)
    z = split_heads(f_h, HGRN_HEADS, HGRN_HEAD_DIM).astype(jnp.float32)
    v = split_heads(i_h, HGRN_HEADS, HGRN_HEAD_DIM).astype(jnp.float32)
    lb = lower_bound.reshape(HGRN_HEADS, 1, HGRN_HEAD_DIM)
    log_f = jnp.log(lb + (1.0 - lb) * jax.nn.sigmoid(z))
    k = (1.0 - lb) * jax.nn.sigmoid(-z)
    o = hgrn2_chunkwise(q, k, v, log_f)
    o = rms_norm(o, out_gain)
    gate = jax.nn.silu(split_heads(g_h, HGRN_HEADS, HGRN_HEAD_DIM).astype(jnp.float32))
    return merge_heads(o * gate)


def setup_inputs(seed: int = 0) -> dict:
    key = jax.random.key(seed)
    ks = jax.random.split(key, 12)
    f32 = jnp.float32
    x = jax.random.normal(ks[0], (BATCH, SEQ, D_MODEL), f32)
    norm_mix = 1.0 + 0.02 * jax.random.normal(ks[1], (DEPTH, D_MODEL), f32)
    w_in = jax.random.normal(ks[2], (DEPTH, D_MODEL, IN_PROJ_WIDTH), f32) * D_MODEL ** -0.5
    attn_out_gain = 1.0 + 0.02 * jax.random.normal(ks[3], (DEPTH, ATTN_WIDTH), f32)
    hgrn_lb_logits = 0.1 * jax.random.normal(ks[4], (DEPTH, HGRN_WIDTH), f32)
    hgrn_out_gain = 1.0 + 0.02 * jax.random.normal(ks[5], (DEPTH, HGRN_HEAD_DIM), f32)
    w_out = jax.random.normal(ks[6], (DEPTH, MIX_WIDTH, D_MODEL), f32) * MIX_WIDTH ** -0.5
    norm_mlp = 1.0 + 0.02 * jax.random.normal(ks[7], (DEPTH, D_MODEL), f32)
    w_up = jax.random.normal(ks[8], (DEPTH, D_MODEL, MLP_HIDDEN), f32) * D_MODEL ** -0.5
    w_down = jax.random.normal(ks[9], (DEPTH, MLP_HIDDEN, D_MODEL), f32) * MLP_HIDDEN ** -0.5
    norm_final = 1.0 + 0.02 * jax.random.normal(ks[10], (D_MODEL,), f32)
    return {'x': x, 'norm_mix': norm_mix, 'w_in': w_in, 'attn_out_gain': attn_out_gain,
            'hgrn_lb_logits': hgrn_lb_logits, 'hgrn_out_gain': hgrn_out_gain,
            'w_out': w_out, 'norm_mlp': norm_mlp, 'w_up': w_up, 'w_down': w_down,
            'norm_final': norm_final}


def reference(x, norm_mix, w_in, attn_out_gain, hgrn_lb_logits, hgrn_out_gain,
              w_out, norm_mlp, w_up, w_down, norm_final):
    seq = x.shape[1]
    positions = jnp.arange(seq, dtype=jnp.int32)
    lower_bounds = hgrn_lower_bounds(hgrn_lb_logits)
    split_points = [ATTN_WIDTH, 2 * ATTN_WIDTH, 3 * ATTN_WIDTH,
                    3 * ATTN_WIDTH + HGRN_WIDTH, 3 * ATTN_WIDTH + 2 * HGRN_WIDTH,
                    3 * ATTN_WIDTH + 3 * HGRN_WIDTH]
    for layer in range(DEPTH):
        h = rms_norm(x, norm_mix[layer])
        proj = h @ w_in[layer]
        q_a, k_a, v_a, q_h, f_h, i_h, g_h = jnp.split(proj, split_points, axis=-1)
        attn = dilated_attention_group(q_a, k_a, v_a, positions)
        attn = rms_norm(attn, attn_out_gain[layer])
        rec = hgrn2_group(q_h, f_h, i_h, g_h, lower_bounds[layer], hgrn_out_gain[layer])
        mixed = jnp.concatenate([attn, rec], axis=-1).astype(x.dtype)
        x = x + mixed @ w_out[layer]
        h = rms_norm(x, norm_mlp[layer])
        x = x + jnp.square(jax.nn.relu(h @ w_up[layer])) @ w_down[layer]
    return rms_norm(x, norm_final)
```

```cpp
#include <hip/hip_runtime.h>
#include <hip/hip_cooperative_groups.h>
#include <cstdio>
#include <cstdint>
#include <cmath>
namespace cg = cooperative_groups;
#ifndef EPI_SKIP
#define EPI_SKIP 0
#endif

namespace pg8 {
#define PG8_LAS __attribute__((address_space(3)))
typedef unsigned short bf16_t;
typedef short bf16x8 __attribute__((ext_vector_type(8)));
typedef float f32x4 __attribute__((ext_vector_type(4)));
typedef unsigned u32x4 __attribute__((ext_vector_type(4)));
constexpr int BM = 256, BK = 64, HALF = 128, HTB = HALF * BK * 2  , STAGE_BYTES = 8 * HTB, NXCD = 8, WGM = 8;

__host__ __device__ __forceinline__ int lds_byte(int r, int c) { const int st = (r >> 4) * 2 + (c >> 5), rr = r & 15, cc = c & 31, ob = rr * 64 + cc * 2; return st * 1024 + (ob ^ (((ob >> 9) & 1) << 5)); }
__host__ __device__ __forceinline__ void stage_rc(int b, int& R, int& C) { const int st = b / 1024, sb = b % 1024, swz = sb ^ (((sb >> 9) & 1) << 5); R = (st >> 1) * 16 + swz / 64; C = (st & 1) * 32 + (swz % 64) / 2; }
__host__ __device__ __forceinline__ int perm32(int rho) { const int n = rho >> 4, i = rho & 15; return 8 * (i >> 2) + 4 * n + (i & 3); }

struct Unit { int pm, pn; };
struct Gemm { const bf16_t* A; const bf16_t* Bt; int M, N, K; };

struct StaticOrder {
    int nM, nN, nwg, G, c, wgm;
    __host__ __device__ void init(int M, int N, int G_, int c_, int wgm_ = 8) { nM = M / BM; nN = N / BM; nwg = nM * nN; G = G_; c = c_; wgm = wgm_; }
    __host__ __device__ bool next(int i, Unit& u) const {
        const long L = (long)i * G + c; if (L >= nwg) return false;
        int wgid = (int)L; { const int q = nwg / NXCD, r = nwg % NXCD, xcd = wgid % NXCD, off = wgid / NXCD; wgid = (xcd < r ? xcd * (q + 1) : r * (q + 1) + (xcd - r) * q) + off; }
        const int nig = wgm * nN, gid = wgid / nig, fm = gid * wgm, gsz = (nM - fm) < wgm ? (nM - fm) : wgm;
        u.pm = fm + ((wgid % nig) % gsz); u.pn = (wgid % nig) / gsz; return true;
    }
    __device__ __forceinline__ void a_ready(const Unit&) const {}
    __device__ __forceinline__ void done(const Unit&) const {}
};

__device__ __forceinline__ unsigned cvt_pk_bf16(float lo, float hi) { unsigned r; asm volatile("v_cvt_pk_bf16_f32 %0, %1, %2" : "=v"(r) : "v"(lo), "v"(hi)); return r; }
template <class Epi, class Sched, bool ALIGN_EPI = false, bool SP2 = false>
__device__ __forceinline__ void gemm_phase(PG8_LAS unsigned char* lds, const Gemm g, const Sched& S, const Epi& E, const int wid) {
    const int lane = (int)__builtin_amdgcn_mbcnt_hi(~0u, __builtin_amdgcn_mbcnt_lo(~0u, 0u)), tid = wid * 64 + lane, wr = wid >> 2, wc = wid & 3, fr = lane & 15, fq = lane >> 4;
    const int K = g.K, nt = K / BK;
    unsigned voffA[2], voffB[2];
#pragma unroll
    for (int i = 0; i < 2; ++i) { int R, C; stage_rc(tid * 16 + i * 8192, R, C); const int Rb = Epi::PERM ? ((R & ~31) + perm32(R & 31)) : R;
        voffA[i] = (unsigned)(R * K + C) * 2u; voffB[i] = (unsigned)(Rb * K + C) * 2u; }
    const size_t kstep = (size_t)(BK * 2);
    const size_t hstep = (size_t)HALF * K * 2;
    const size_t tstep = 2 * hstep;
    const unsigned ldsw = (unsigned)wid * 1024u;
    const int aoff = lds_byte(wr * 64 + fr, fq * 8), boff = lds_byte(wc * 32 + fr, fq * 8);
#define PG8_SA(b, h) (((b) * 2 + (h)) * HTB)
#define PG8_SB(b, h) ((4 + (b) * 2 + (h)) * HTB)
#define PG8_STAGE(bufoff, gbase, voff) do { _Pragma("unroll") for (int _i = 0; _i < 2; ++_i) \
        __builtin_amdgcn_global_load_lds((const unsigned*)((const char*)(gbase) + (voff)[_i]), (PG8_LAS unsigned*)(lds + (bufoff) + ldsw + _i * 8192), 16, 0, 0); } while (0)
#define PG8_LDA(dst, b, h) do { _Pragma("unroll") for (int m = 0; m < 4; ++m) _Pragma("unroll") for (int k = 0; k < 2; ++k) dst[m][k] = *(const PG8_LAS bf16x8*)(lds + PG8_SA(b, h) + aoff + m * 2048 + k * 1024); } while (0)
#define PG8_LDB(dst, b, h) do { _Pragma("unroll") for (int n = 0; n < 2; ++n) _Pragma("unroll") for (int k = 0; k < 2; ++k) dst[n][k] = *(const PG8_LAS bf16x8*)(lds + PG8_SB(b, h) + boff + n * 2048 + k * 1024); } while (0)
#define PG8_MMA(ai, bj, At, Bt) do { __builtin_amdgcn_s_setprio(1); _Pragma("unroll") for (int m = 0; m < 4; ++m) _Pragma("unroll") for (int n = 0; n < 2; ++n) _Pragma("unroll") for (int k = 0; k < 2; ++k) \
        acc[ai][bj][m][n] = __builtin_amdgcn_mfma_f32_16x16x32_bf16(Bt[n][k], At[m][k], acc[ai][bj][m][n], 0, 0, 0); __builtin_amdgcn_s_setprio(0); } while (0)
#define PG8_WAIT_V(n) asm volatile("s_waitcnt vmcnt(" #n ")" ::: "memory")
#define PG8_WAIT_L(n) asm volatile("s_waitcnt lgkmcnt(" #n ")" ::: "memory")
#define PG8_BAR __builtin_amdgcn_s_barrier()
#define PG8_SCHED __builtin_amdgcn_sched_barrier(0)
    Unit cur, nxt; int ui = 0;
    if (!S.next(0, cur)) return;
    f32x4 acc[2][2][4][2];
#pragma unroll
    for (int a = 0; a < 2; ++a)
#pragma unroll
        for (int b = 0; b < 2; ++b)
#pragma unroll
            for (int m = 0; m < 4; ++m)
#pragma unroll
                for (int n = 0; n < 2; ++n) acc[a][b][m][n] = (f32x4){0.f, 0.f, 0.f, 0.f};
    bf16x8 At[4][2], B0[2][2], B1[2][2];
    const char* cA = (const char*)g.A + (size_t)cur.pm * tstep; const char* cB = (const char*)g.Bt + (size_t)cur.pn * tstep;
    S.a_ready(cur);
    if constexpr (SP2) {
        PG8_STAGE(PG8_SB(0, 0), cB, voffB); PG8_STAGE(PG8_SB(0, 1), cB + hstep, voffB); PG8_STAGE(PG8_SA(0, 0), cA, voffA); PG8_STAGE(PG8_SA(0, 1), cA + hstep, voffA);
        if (wr == 1) PG8_BAR;
        PG8_WAIT_V(2); PG8_BAR;
        PG8_STAGE(PG8_SB(1, 0), cB + kstep, voffB); PG8_STAGE(PG8_SA(1, 0), cA + kstep, voffA); PG8_STAGE(PG8_SB(1, 1), cB + hstep + kstep, voffB);
        PG8_WAIT_V(6); PG8_BAR;
    } else {
        PG8_STAGE(PG8_SB(0, 0), cB, voffB); PG8_STAGE(PG8_SA(0, 0), cA, voffA); PG8_STAGE(PG8_SB(0, 1), cB + hstep, voffB); PG8_STAGE(PG8_SA(0, 1), cA + hstep, voffA);
        if (wr == 1) PG8_BAR;
        PG8_WAIT_V(4); PG8_BAR;
        PG8_STAGE(PG8_SB(1, 0), cB + kstep, voffB); PG8_STAGE(PG8_SA(1, 0), cA + kstep, voffA); PG8_STAGE(PG8_SB(1, 1), cB + hstep + kstep, voffB);
        PG8_WAIT_V(6); PG8_BAR;
    }
    for (;;) {
        const bool has_next = S.next(ui + 1, nxt);
        const char* nA = has_next ? (const char*)g.A + (size_t)nxt.pm * tstep : cA; const char* nB = has_next ? (const char*)g.Bt + (size_t)nxt.pn * tstep : cB;
        for (int t = 0; t < nt; t += 2) {
            const bool last = (t == nt - 2);
            const char* a1 = cA + (size_t)(t + 1) * kstep;
            const char* a2 = last ? nA : cA + (size_t)(t + 2) * kstep; const char* b2 = last ? nB : cB + (size_t)(t + 2) * kstep;
            const char* a3 = a2 + kstep; const char* b3 = b2 + kstep;
            if (last && has_next) S.a_ready(nxt);
            if constexpr (SP2) {
            PG8_LDB(B0, 0, 0); PG8_LDB(B1, 0, 1); PG8_SCHED; PG8_LDA(At, 0, 0); PG8_STAGE(PG8_SA(1, 1), a1 + hstep, voffA);
            PG8_WAIT_V(8); PG8_WAIT_L(0); PG8_BAR; PG8_MMA(0, 0, At, B0); PG8_MMA(0, 1, At, B1); PG8_BAR; PG8_SCHED;
            PG8_LDA(At, 0, 1); PG8_STAGE(PG8_SB(0, 0), b2, voffB); PG8_STAGE(PG8_SB(0, 1), b2 + hstep, voffB); PG8_STAGE(PG8_SA(0, 0), a2, voffA);
            PG8_WAIT_V(8); PG8_WAIT_L(0); PG8_BAR; PG8_MMA(1, 0, At, B0); PG8_MMA(1, 1, At, B1); PG8_BAR; PG8_SCHED;
            PG8_LDB(B0, 1, 0); PG8_LDB(B1, 1, 1); PG8_SCHED; PG8_LDA(At, 1, 0); PG8_STAGE(PG8_SA(0, 1), a2 + hstep, voffA);
            PG8_WAIT_V(8); PG8_WAIT_L(0); PG8_BAR; PG8_MMA(0, 0, At, B0); PG8_MMA(0, 1, At, B1); PG8_BAR; PG8_SCHED;
            PG8_LDA(At, 1, 1); PG8_STAGE(PG8_SB(1, 0), b3, voffB); PG8_STAGE(PG8_SB(1, 1), b3 + hstep, voffB); PG8_STAGE(PG8_SA(1, 0), a3, voffA);
            PG8_WAIT_V(8); PG8_WAIT_L(0); PG8_BAR; PG8_MMA(1, 0, At, B0); PG8_MMA(1, 1, At, B1); PG8_BAR; PG8_SCHED;
            } else {
            PG8_LDB(B0, 0, 0); PG8_SCHED; PG8_LDA(At, 0, 0); PG8_STAGE(PG8_SA(1, 1), a1 + hstep, voffA);
            PG8_WAIT_L(8); PG8_BAR; PG8_WAIT_L(0); PG8_MMA(0, 0, At, B0); PG8_BAR; PG8_SCHED;
            PG8_LDB(B1, 0, 1); PG8_STAGE(PG8_SB(0, 0), b2, voffB);
            PG8_BAR; PG8_WAIT_L(0); PG8_MMA(0, 1, At, B1); PG8_BAR;
            PG8_LDA(At, 0, 1); PG8_STAGE(PG8_SA(0, 0), a2, voffA);
            PG8_BAR; PG8_WAIT_L(0); PG8_MMA(1, 0, At, B0); PG8_BAR; PG8_SCHED;
            PG8_STAGE(PG8_SB(0, 1), b2 + hstep, voffB);
            PG8_WAIT_V(6); PG8_BAR; PG8_MMA(1, 1, At, B1); PG8_BAR;
            PG8_LDB(B0, 1, 0); PG8_SCHED; PG8_LDA(At, 1, 0); PG8_STAGE(PG8_SA(0, 1), a2 + hstep, voffA);
            PG8_WAIT_L(8); PG8_BAR; PG8_WAIT_L(0); PG8_MMA(0, 0, At, B0); PG8_BAR; PG8_SCHED;
            PG8_LDB(B1, 1, 1); PG8_STAGE(PG8_SB(1, 0), b3, voffB);
            PG8_BAR; PG8_WAIT_L(0); PG8_MMA(0, 1, At, B1); PG8_BAR;
            PG8_LDA(At, 1, 1); PG8_STAGE(PG8_SA(1, 0), a3, voffA);
            PG8_BAR; PG8_WAIT_L(0); PG8_MMA(1, 0, At, B0); PG8_BAR; PG8_SCHED;
            PG8_STAGE(PG8_SB(1, 1), b3 + hstep, voffB);
            PG8_WAIT_V(6); PG8_BAR; PG8_MMA(1, 1, At, B1); PG8_BAR;
            }
        }
        if constexpr (ALIGN_EPI) { if (wr == 0) PG8_BAR; }
        if constexpr (!Epi::AFTER_DRAIN) { E(acc, cur, wr, wc, fr, fq); S.done(cur); }
        if (!has_next) break;
#pragma unroll
        for (int a = 0; a < 2; ++a)
#pragma unroll
            for (int b = 0; b < 2; ++b)
#pragma unroll
                for (int m = 0; m < 4; ++m)
#pragma unroll
                    for (int n = 0; n < 2; ++n) acc[a][b][m][n] = (f32x4){0.f, 0.f, 0.f, 0.f};
        cur = nxt; cA = nA; cB = nB; ++ui;
        if constexpr (ALIGN_EPI) { if (wr == 1) PG8_BAR; }
    }
    PG8_WAIT_V(0);
    if constexpr (!ALIGN_EPI) { if (wr == 0) PG8_BAR; }
    PG8_BAR;
    if constexpr (Epi::AFTER_DRAIN) { E.fused(acc, cur, wr, wc, fr, fq, lds, wid, lane); S.done(cur); }
#undef PG8_SA
#undef PG8_SB
#undef PG8_STAGE
#undef PG8_LDA
#undef PG8_LDB
#undef PG8_MMA
#undef PG8_WAIT_V
#undef PG8_WAIT_L
#undef PG8_BAR
#undef PG8_SCHED
}
}


constexpr int NB = 8, SEQ = 4096, D = 1024, M = NB * SEQ, NIN = 3584, FF = 4096, NLAYER = 2;
constexpr int NWAVES = 8;
constexpr float NEPS = 1e-6f;
#ifndef N_LAUNCH_MODE
#define N_LAUNCH_MODE 1
#endif

constexpr size_t MiB = 1u << 20;
constexpr size_t WS_SS = 0;
constexpr size_t WS_BAR = 768 * 1024;
constexpr size_t WS_ROPE = 1 * MiB;
constexpr size_t WS_WIN = 2 * MiB;
constexpr size_t WS_WOUT = 16 * MiB;
constexpr size_t WS_WUP = 20 * MiB;
constexpr size_t WS_WDN = 36 * MiB;
constexpr size_t WS_XB = 52 * MiB;
constexpr size_t WS_A = 116 * MiB;
constexpr size_t WS_OP = 372 * MiB;
constexpr size_t WS_REC = 468 * MiB;
constexpr size_t WS_LSE = 500 * MiB;
constexpr size_t WS_DEC = 503 * MiB;
constexpr size_t WS_END = 507 * MiB;

constexpr int LDS_BYTES = 147456;

#define LAS __attribute__((address_space(3)))
typedef unsigned short bf16;
typedef unsigned u32x4 __attribute__((ext_vector_type(4)));
typedef unsigned u32x2 __attribute__((ext_vector_type(2)));
typedef float f32x4 __attribute__((ext_vector_type(4)));
typedef float f32x2 __attribute__((ext_vector_type(2)));
typedef float f32x16 __attribute__((ext_vector_type(16)));
typedef short bf16x8 __attribute__((ext_vector_type(8)));
typedef short s16x4 __attribute__((ext_vector_type(4)));
typedef __bf16 nbf2 __attribute__((ext_vector_type(2)));

__device__ __forceinline__ unsigned pkbf(float lo, float hi) { f32x2 v = {lo, hi}; nbf2 r = __builtin_convertvector(v, nbf2); return __builtin_bit_cast(unsigned, r); }
__device__ __forceinline__ float bflo(unsigned u) { return __uint_as_float(u << 16); }
__device__ __forceinline__ float bfhi(unsigned u) { return __uint_as_float(u & 0xffff0000u); }
__device__ __forceinline__ float fexp(float x) { return __builtin_amdgcn_exp2f(x * 1.4426950408889634f); }
__device__ __forceinline__ float frcp(float x) { return __builtin_amdgcn_rcpf(x); }
__device__ __forceinline__ float flog(float x) { return __builtin_amdgcn_logf(x) * 0.6931471805599453f; }
template <int N> __device__ __forceinline__ float row_shr(float v) { return __int_as_float(__builtin_amdgcn_update_dpp(0, __float_as_int(v), 0x110 + N, 0xf, 0xf, true)); }

namespace pg8 {
struct EpiIn {
    static constexpr bool PERM = true, AFTER_DRAIN = false;
    const float* ss; const float* rope; const float* lbl; int layer;
    unsigned char* wa; float* DEC;
    __device__ __forceinline__ void operator()(const f32x4 (&acc)[2][2][4][2], const Unit& u, int wr, int wc, int fr, int fq) const {
        asm volatile("" : "+v"(fr), "+v"(fq));
        const int row0 = u.pm * BM + wr * 64 + fr;
#define RS_AT(ai, m) __builtin_amdgcn_rsqf(ss[row0 + (ai) * HALF + (m) * 16] * (1.0f / 1024.0f) + 1e-6f)
        const int pn = u.pn;
        bf16_t *Q = (bf16_t*)wa, *K = (bf16_t*)(wa + (32u << 20)), *V = (bf16_t*)(wa + (64u << 20)), *QH = (bf16_t*)(wa + (96u << 20)), *KH = (bf16_t*)(wa + (128u << 20)),
               *KOT = (bf16_t*)(wa + (160u << 20)), *VT = (bf16_t*)(wa + (192u << 20)), *GATE = (bf16_t*)(wa + (224u << 20));
        if (pn < 4 && !(EPI_SKIP & 1)) {
            bf16_t* base = (pn >> 1) ? K : Q; const float sc = (pn >> 1) ? 1.0f : 0.125f;
            const int colt = (pn & 1) * 256 + wc * 32 + 8 * fq, i0 = 16 * (wc & 1) + 4 * fq;
#pragma unroll
            for (int ai = 0; ai < 2; ++ai)
#pragma unroll
                for (int m = 0; m < 4; ++m) {
                    const int row = row0 + ai * HALF + m * 16, pos = row & (4096 - 1);
                    const f32x4* rp = (const f32x4*)(rope + (size_t)(pos * 32 + i0) * 2);
                    const f32x4 c0 = rp[0], c1 = rp[1]; const float r = RS_AT(ai, m) * sc;
#pragma unroll
                    for (int bj = 0; bj < 2; ++bj) {
                        const f32x4 a = acc[ai][bj][m][0] * r, b = acc[ai][bj][m][1] * r; u32x4 w;
                        w.x = cvt_pk_bf16(a[0] * c0[0] - a[1] * c0[1], a[0] * c0[1] + a[1] * c0[0]);
                        w.y = cvt_pk_bf16(a[2] * c0[2] - a[3] * c0[3], a[2] * c0[3] + a[3] * c0[2]);
                        w.z = cvt_pk_bf16(b[0] * c1[0] - b[1] * c1[1], b[0] * c1[1] + b[1] * c1[0]);
                        w.w = cvt_pk_bf16(b[2] * c1[2] - b[3] * c1[3], b[2] * c1[3] + b[3] * c1[2]);
                        *(u32x4*)(base + (size_t)row * 512 + colt + bj * HALF) = w;
                    }
                }
        } else if ((pn < 6 || pn >= 12) && !(EPI_SKIP & 2)) {
            const bool gate = pn >= 12; bf16_t* base = gate ? GATE : V;
            const int colt = ((pn - (gate ? 12 : 4)) & 1) * 256 + wc * 32 + 8 * fq;
#pragma unroll
            for (int ai = 0; ai < 2; ++ai)
#pragma unroll
                for (int m = 0; m < 4; ++m) {
                    const int row = row0 + ai * HALF + m * 16; const float r = RS_AT(ai, m);
#pragma unroll
                    for (int bj = 0; bj < 2; ++bj) {
                        f32x4 a = acc[ai][bj][m][0] * r, b = acc[ai][bj][m][1] * r;
                        if (gate) {
#pragma unroll
                            for (int e = 0; e < 4; ++e) { a[e] = a[e] * frcp(1.0f + fexp(-a[e])); b[e] = b[e] * frcp(1.0f + fexp(-b[e])); }
                        }
                        u32x4 w; w.x = cvt_pk_bf16(a[0], a[1]); w.y = cvt_pk_bf16(a[2], a[3]); w.z = cvt_pk_bf16(b[0], b[1]); w.w = cvt_pk_bf16(b[2], b[3]);
                        *(u32x4*)(base + (size_t)row * 512 + colt + bj * HALF) = w;
                    }
                }
        } else if (pn >= 10 && !(EPI_SKIP & 4)) {
            const int c0 = (pn - 10) * 256 + wc * 32 + 8 * fq;
#pragma unroll
            for (int ai = 0; ai < 2; ++ai)
#pragma unroll
                for (int m = 0; m < 4; ++m) {
                    const int rowb = u.pm * BM + wr * 64 + ai * HALF + m * 16, chunk = rowb >> 4; const float r = RS_AT(ai, m);
#pragma unroll
                    for (int bj = 0; bj < 2; ++bj) {
                        const f32x4 a = acc[ai][bj][m][0] * r, b = acc[ai][bj][m][1] * r;
                        bf16_t* p = VT + ((size_t)chunk * 512 + c0 + bj * HALF) * 16 + fr;
                        const unsigned w0 = cvt_pk_bf16(a[0], a[1]), w1 = cvt_pk_bf16(a[2], a[3]), w2 = cvt_pk_bf16(b[0], b[1]), w3 = cvt_pk_bf16(b[2], b[3]);
                        p[0] = (bf16_t)w0; p[16] = (bf16_t)(w0 >> 16); p[32] = (bf16_t)w1; p[48] = (bf16_t)(w1 >> 16);
                        p[64] = (bf16_t)w2; p[80] = (bf16_t)(w2 >> 16); p[96] = (bf16_t)w3; p[112] = (bf16_t)(w3 >> 16);
                    }
                }
        } else if (!(EPI_SKIP & 8)) {
            const int hd = pn - 6;
#pragma unroll
            for (int bj = 0; bj < 2; ++bj) {
                const int ch = 128 * hd + 64 * bj + 16 * wc + 4 * fq;
                const int chp = 128 * hd + 8 * (4 * (2 * bj + (wc >> 1)) + fq) + 4 * (wc & 1);
                float lb[4];
#pragma unroll
                for (int e = 0; e < 4; ++e) lb[e] = layer == 0 ? 0.0f : frcp(1.0f + fexp(lbl[ch + e] - lbl[512 + ch + e]));
#pragma unroll
                for (int ai = 0; ai < 2; ++ai)
#pragma unroll
                    for (int m = 0; m < 4; ++m) {
                        const int rowb = u.pm * BM + wr * 64 + ai * HALF + m * 16, row = rowb + fr, chunk = rowb >> 4; const float r = RS_AT(ai, m);
                        const f32x4 qv = acc[ai][bj][m][0] * r, zv = acc[ai][bj][m][1] * r;
                        float qh[4], kh[4], ko[4], dc[4];
#pragma unroll
                        for (int e = 0; e < 4; ++e) {
                            const float z = fminf(fmaxf(zv[e], -30.0f), 30.0f);
                            const float t = fexp(-z), s = frcp(1.0f + t), sn = t * s;
                            const float f = lb[e] + (1.0f - lb[e]) * s, kk = (1.0f - lb[e]) * sn;
                            float g = flog(f);
                            g += row_shr<1>(g); g += row_shr<2>(g); g += row_shr<4>(g); g += row_shr<8>(g);
                            g = fmaxf(g, -80.0f);
                            const float gl = __shfl(g, 15, 16);
                            const float q = qv[e], qs = q * frcp(1.0f + fexp(-q)) * 0.08838834764831845f;
                            qh[e] = qs * fexp(g); kh[e] = kk * fexp(-g); ko[e] = kk * fexp(gl - g); dc[e] = fexp(gl);
                        }
                        u32x2 w; w.x = cvt_pk_bf16(qh[0], qh[1]); w.y = cvt_pk_bf16(qh[2], qh[3]); *(u32x2*)(QH + (size_t)row * 512 + chp) = w;
                        w.x = cvt_pk_bf16(kh[0], kh[1]); w.y = cvt_pk_bf16(kh[2], kh[3]); *(u32x2*)(KH + (size_t)row * 512 + chp) = w;
                        const unsigned k0 = cvt_pk_bf16(ko[0], ko[1]), k1 = cvt_pk_bf16(ko[2], ko[3]);
                        bf16_t* p = KOT + ((size_t)chunk * 512 + ch) * 16 + fr;
                        p[0] = (bf16_t)k0; p[16] = (bf16_t)(k0 >> 16); p[32] = (bf16_t)k1; p[48] = (bf16_t)(k1 >> 16);
                        if (fr == 15) { u32x2 dw; dw.x = cvt_pk_bf16(dc[0], dc[1]); dw.y = cvt_pk_bf16(dc[2], dc[3]); *(u32x2*)((bf16_t*)DEC + (size_t)chunk * 512 + ch) = dw; }
                        asm volatile("" ::: "memory");
                    }
            }
        }
    }
};
struct EpiRes {
    static constexpr bool PERM = true, AFTER_DRAIN = false;
    const float* xin; float* xout; bf16_t* xb; float* ssout;
    __device__ __forceinline__ void operator()(const f32x4 (&acc)[2][2][4][2], const Unit& u, int wr, int wc, int fr, int fq) const {
        asm volatile("" : "+v"(fr), "+v"(fq));
        const int row0 = u.pm * BM + wr * 64 + fr, col0 = u.pn * BM + wc * 32 + 8 * fq;
#pragma unroll
        for (int ai = 0; ai < 2; ++ai)
#pragma unroll
            for (int m = 0; m < 4; ++m) {
                const int row = row0 + ai * HALF + m * 16; float part = 0.f;
#pragma unroll
                for (int bj = 0; bj < 2; ++bj) {
                    const size_t off = (size_t)row * 1024 + col0 + bj * HALF;
                    f32x4 a = *(const f32x4*)(xin + off), b = *(const f32x4*)(xin + off + 4);
                    a += acc[ai][bj][m][0]; b += acc[ai][bj][m][1];
                    *(f32x4*)(xout + off) = a; *(f32x4*)(xout + off + 4) = b;
                    part += (a[0] * a[0] + a[1] * a[1]) + (a[2] * a[2] + a[3] * a[3]) + (b[0] * b[0] + b[1] * b[1]) + (b[2] * b[2] + b[3] * b[3]);
                    if (xb) { u32x4 w; w.x = cvt_pk_bf16(a[0], a[1]); w.y = cvt_pk_bf16(a[2], a[3]); w.z = cvt_pk_bf16(b[0], b[1]); w.w = cvt_pk_bf16(b[2], b[3]);
                        *(u32x4*)(xb + off) = w; }
                }
                part += __shfl_xor(part, 16); part += __shfl_xor(part, 32);
                if (fq == 0) atomicAdd(ssout + row, part);
            }
    }
};
struct EpiUp {
    static constexpr bool PERM = true, AFTER_DRAIN = false;
    const float* ss; bf16_t* H;
    __device__ __forceinline__ void operator()(const f32x4 (&acc)[2][2][4][2], const Unit& u, int wr, int wc, int fr, int fq) const {
        asm volatile("" : "+v"(fr), "+v"(fq));
        const int row0 = u.pm * BM + wr * 64 + fr, col0 = u.pn * BM + wc * 32 + 8 * fq;
#pragma unroll
        for (int ai = 0; ai < 2; ++ai)
#pragma unroll
            for (int m = 0; m < 4; ++m) {
                const int row = row0 + ai * HALF + m * 16; const float r = __builtin_amdgcn_rsqf(ss[row] * (1.0f / 1024.0f) + 1e-6f);
#pragma unroll
                for (int bj = 0; bj < 2; ++bj) {
                    f32x4 a = acc[ai][bj][m][0] * r, b = acc[ai][bj][m][1] * r;
#pragma unroll
                    for (int e = 0; e < 4; ++e) { a[e] = fmaxf(a[e], 0.f); a[e] *= a[e]; b[e] = fmaxf(b[e], 0.f); b[e] *= b[e]; }
                    u32x4 w; w.x = cvt_pk_bf16(a[0], a[1]); w.y = cvt_pk_bf16(a[2], a[3]); w.z = cvt_pk_bf16(b[0], b[1]); w.w = cvt_pk_bf16(b[2], b[3]);
                    *(u32x4*)(H + (size_t)row * 4096 + col0 + bj * HALF) = w;
                }
            }
    }
};
}

__device__ __forceinline__ float wave_sum(float v) {
#pragma unroll
    for (int o = 1; o < 64; o <<= 1) v += __shfl_xor(v, o);
    return v;
}
__device__ __forceinline__ int win_src_col(int c) {
    if (c < 1024) { const int p = c & 63; return (c & ~63) + (p >> 1) + 32 * (p & 1); }
    if (c >= 1536 && c < 2560) { const int cl = c - 1536, g = cl >> 3, sub = cl & 7; return (sub < 4 ? 1536 : 2048) + 4 * g + (sub & 3); }
    return c;
}
template <bool PERMC>
__device__ __forceinline__ void p0_transpose_item(const float* W, int K, int N, bf16* WT, const float* gain, LAS float* scr, int item, int lane) {
    const int nblk = N / 32, kb = item / nblk, nb = item % nblk, k0 = 64 * kb, n0 = 32 * nb;
    const int pc = n0 + (lane & 31), sc = PERMC ? win_src_col(pc) : pc;
    float wv[32];
#pragma unroll
    for (int i = 0; i < 32; ++i) wv[i] = W[(size_t)(k0 + 2 * i + (lane >> 5)) * N + sc];
#pragma unroll
    for (int i = 0; i < 32; ++i) { const int kk = 2 * i + (lane >> 5); const float g = gain ? gain[k0 + kk] : 1.0f; scr[kk * 33 + (lane & 31)] = wv[i] * g; }
    asm volatile("s_waitcnt lgkmcnt(0)" ::: "memory");
    const int c = lane & 7;
#pragma unroll
    for (int j = 0; j < 4; ++j) { const int n = (lane >> 3) + 8 * j; const LAS float* s = scr + (8 * c) * 33 + n;
        u32x4 o; o.x = pkbf(s[0 * 33], s[1 * 33]); o.y = pkbf(s[2 * 33], s[3 * 33]); o.z = pkbf(s[4 * 33], s[5 * 33]); o.w = pkbf(s[6 * 33], s[7 * 33]);
        *(u32x4*)(WT + (size_t)(n0 + n) * K + k0 + 8 * c) = o; }
    asm volatile("s_waitcnt lgkmcnt(0)" ::: "memory");
}

struct Args {
    const float* in[11]; float* out; unsigned char* ws; float inv_freq[32]; int ph_lo, ph_hi;
};

__device__ __forceinline__ void p0_prologue(const Args& A, LAS unsigned char* lds, int wave, int lane) {
    LAS float* scr = (LAS float*)(lds + wave * 16384);
    const int gw = blockIdx.x * NWAVES + wave, NGW = gridDim.x * NWAVES;
    unsigned char* ws = A.ws;
    const float *norm_mix = A.in[1], *w_in = A.in[2], *w_out = A.in[6], *norm_mlp = A.in[7], *w_up = A.in[8], *w_down = A.in[9];
    constexpr int I_IN = 16 * 112, I_OUT = 16 * 32, I_UP = 16 * 128, I_DN = 64 * 32, I_L = I_IN + I_OUT + I_UP + I_DN;
    for (int it = gw; it < 2 * I_L; it += NGW) {
        const int l = it / I_L; int r = it % I_L;
        if (r < I_IN) { p0_transpose_item<true>(w_in + (size_t)l * D * NIN, D, NIN, (bf16*)(ws + WS_WIN) + (size_t)l * NIN * D, norm_mix + l * D, scr, r, lane); continue; } r -= I_IN;
        if (r < I_OUT) { p0_transpose_item<false>(w_out + (size_t)l * D * D, D, D, (bf16*)(ws + WS_WOUT) + (size_t)l * D * D, nullptr, scr, r, lane); continue; } r -= I_OUT;
        if (r < I_UP) { p0_transpose_item<false>(w_up + (size_t)l * D * FF, D, FF, (bf16*)(ws + WS_WUP) + (size_t)l * FF * D, norm_mlp + l * D, scr, r, lane); continue; } r -= I_UP;
        p0_transpose_item<false>(w_down + (size_t)l * FF * D, FF, D, (bf16*)(ws + WS_WDN) + (size_t)l * D * FF, nullptr, scr, r, lane);
    }
    const float* x = A.in[0]; bf16* xb = (bf16*)(ws + WS_XB); float* ss = (float*)(ws + WS_SS);
    for (int m = gw; m < M; m += 2 * NGW) {
        const int m2 = m + NGW;
        const f32x4* xr = (const f32x4*)(x + (size_t)m * D) + lane; const f32x4* xr2 = (const f32x4*)(x + (size_t)m2 * D) + lane;
        f32x4 v[4], w[4];
#pragma unroll
        for (int j = 0; j < 4; ++j) { v[j] = xr[64 * j]; w[j] = xr2[64 * j]; }
        unsigned long long* o8 = (unsigned long long*)(xb + (size_t)m * D) + lane; unsigned long long* p8 = (unsigned long long*)(xb + (size_t)m2 * D) + lane;
        float s = 0.f, t = 0.f;
#pragma unroll
        for (int j = 0; j < 4; ++j) {
            s += (v[j][0] * v[j][0] + v[j][1] * v[j][1]) + (v[j][2] * v[j][2] + v[j][3] * v[j][3]); t += (w[j][0] * w[j][0] + w[j][1] * w[j][1]) + (w[j][2] * w[j][2] + w[j][3] * w[j][3]);
            o8[64 * j] = (unsigned long long)pkbf(v[j][0], v[j][1]) | ((unsigned long long)pkbf(v[j][2], v[j][3]) << 32);
            p8[64 * j] = (unsigned long long)pkbf(w[j][0], w[j][1]) | ((unsigned long long)pkbf(w[j][2], w[j][3]) << 32); }
        s = wave_sum(s); t = wave_sum(t);
        if (lane == 0) { ss[m] = s; ss[m2] = t; }
    }
    const int gt = blockIdx.x * (NWAVES * 64) + wave * 64 + lane, NGT = gridDim.x * NWAVES * 64;
    for (int i = gt; i < 4 * M; i += NGT) ss[M + i] = 0.f;
    float* rope = (float*)(ws + WS_ROPE);
    for (int i = gt; i < SEQ * 32; i += NGT) {
        const int pos = i >> 5, k = i & 31;
        float ifq = 0.f;
#pragma unroll
        for (int q = 0; q < 32; ++q) if (k == q) ifq = A.inv_freq[q];
        const float ang = (float)pos * ifq;
        const double rev = (double)ang * 0.15915494309189535; const float fr = (float)(rev - __builtin_rint(rev));
        rope[2 * i] = __builtin_amdgcn_cosf(fr); rope[2 * i + 1] = __builtin_amdgcn_sinf(fr);
    }
}

constexpr int VRS = 144;
__device__ __forceinline__ int crow(int i, int h) { return (i & 3) + 8 * (i >> 2) + 4 * h; }
__device__ __forceinline__ void attn_qk_pv(const bf16x8 (&kf)[4], const bf16x8 (&qf)[4], const bf16x8 va00, const bf16x8 va01, const bf16x8 va10, const bf16x8 va11,
                                           f32x16& o0, f32x16& o1, float& mrun, float& lrun, int mode, int r32, int h2) {
    f32x16 sc;
#pragma unroll
    for (int i = 0; i < 16; ++i) sc[i] = 0.f;
    __builtin_amdgcn_s_setprio(1);
#pragma unroll
    for (int s = 0; s < 4; ++s) sc = __builtin_amdgcn_mfma_f32_32x32x16_bf16(kf[s], qf[s], sc, 0, 0, 0);
    __builtin_amdgcn_s_setprio(0);
    if (mode == 1) {
#pragma unroll
        for (int i = 0; i < 16; ++i) if (crow(i, h2) < r32) sc[i] = -1e30f;
    }
    if (mode == 2) {
#pragma unroll
        for (int i = 0; i < 16; ++i) if (crow(i, h2) > r32) sc[i] = -1e30f;
    }
    float mx = sc[0];
#pragma unroll
    for (int i = 1; i < 16; ++i) mx = fmaxf(mx, sc[i]);
    mx = fmaxf(mx, __shfl_xor(mx, 32));
    const float mn = fmaxf(mrun, mx), alpha = fexp(mrun - mn); mrun = mn;
    float ps = 0.f;
#pragma unroll
    for (int i = 0; i < 16; ++i) { sc[i] = fexp(sc[i] - mn); ps += sc[i]; }
    lrun = lrun * alpha + ps;
#pragma unroll
    for (int i = 0; i < 16; ++i) { o0[i] *= alpha; o1[i] *= alpha; }
    u32x4 pw0, pw1;
    pw0.x = pkbf(sc[0], sc[1]); pw0.y = pkbf(sc[2], sc[3]); pw0.z = pkbf(sc[4], sc[5]); pw0.w = pkbf(sc[6], sc[7]);
    pw1.x = pkbf(sc[8], sc[9]); pw1.y = pkbf(sc[10], sc[11]); pw1.z = pkbf(sc[12], sc[13]); pw1.w = pkbf(sc[14], sc[15]);
    const bf16x8 pb0 = __builtin_bit_cast(bf16x8, pw0), pb1 = __builtin_bit_cast(bf16x8, pw1);
    __builtin_amdgcn_s_setprio(1);
    o0 = __builtin_amdgcn_mfma_f32_32x32x16_bf16(va00, pb0, o0, 0, 0, 0); o0 = __builtin_amdgcn_mfma_f32_32x32x16_bf16(va01, pb1, o0, 0, 0, 0);
    o1 = __builtin_amdgcn_mfma_f32_32x32x16_bf16(va10, pb0, o1, 0, 0, 0); o1 = __builtin_amdgcn_mfma_f32_32x32x16_bf16(va11, pb1, o1, 0, 0, 0);
    __builtin_amdgcn_s_setprio(0);
}
__device__ __forceinline__ void attn_store(const f32x16& o0, const f32x16& o1, float mrun, float lrun, bf16* OP, float* LSE, int p, size_t tokq, int h, int h2) {
    const float lt = lrun + __shfl_xor(lrun, 32), inv = 1.0f / lt;
    bf16* op = OP + ((size_t)p * M + tokq) * 512 + h * 64 + 4 * h2;
#pragma unroll
    for (int g = 0; g < 4; ++g) {
        u32x2 w; w.x = pkbf(o0[4 * g] * inv, o0[4 * g + 1] * inv); w.y = pkbf(o0[4 * g + 2] * inv, o0[4 * g + 3] * inv); *(u32x2*)(op + 8 * g) = w;
        w.x = pkbf(o1[4 * g] * inv, o1[4 * g + 1] * inv); w.y = pkbf(o1[4 * g + 2] * inv, o1[4 * g + 3] * inv); *(u32x2*)(op + 32 + 8 * g) = w;
    }
    if (h2 == 0) LSE[((size_t)p * M + tokq) * 8 + h] = mrun + flog(lt);
}
constexpr int ATT_ITEMS = NB * 8 * 3 * 64;
__device__ __forceinline__ void attn_item(int item, const bf16* Q, const bf16* K, const bf16* V, bf16* OP, float* LSE, LAS unsigned char* vl, int lane) {
    const int x = item & 63; const int t3 = item >> 6; const int p = t3 % 3, bh = t3 / 3, b = bh >> 3, h = bh & 7;
    const int dsh = 2 * p, per2 = 64 >> dsh, res = x >> (6 - dsh), qp2 = x & (per2 - 1), q0 = qp2 * 64;
    const int r32 = lane & 31, h2 = lane >> 5;
    const size_t tokA = (size_t)b * SEQ + ((size_t)(q0 + r32) << dsh) + res, tokB = (size_t)b * SEQ + ((size_t)(q0 + 32 + r32) << dsh) + res;
    bf16x8 qfA[4], qfB[4];
    { const bf16* qa = Q + tokA * 512 + h * 64 + 8 * h2; const bf16* qb = Q + tokB * 512 + h * 64 + 8 * h2;
#pragma unroll
      for (int s = 0; s < 4; ++s) { qfA[s] = *(const bf16x8*)(qa + 16 * s); qfB[s] = *(const bf16x8*)(qb + 16 * s); } }
    f32x16 oA0, oA1, oB0, oB1;
#pragma unroll
    for (int i = 0; i < 16; ++i) { oA0[i] = 0.f; oA1[i] = 0.f; oB0[i] = 0.f; oB1[i] = 0.f; }
    float mA = -1e30f, lA = 0.f, mB = -1e30f, lB = 0.f;
    const int j_lo = q0 >= 128 ? 0 : (128 - q0) >> 5;
    const unsigned vbase = (unsigned)(size_t)vl;
    const int i16 = lane & 15, tq = i16 >> 2, tp = i16 & 3, blk = (lane >> 4) & 1;
    const unsigned traddr = vbase + (4 * h2 + tq) * VRS + 32 * blk + 8 * tp;
    bf16x8 kf[4]; u32x4 vv[4];
#define ATT_LOAD(KF, VV, tile) do { const int kt0_ = q0 - 128 + 32 * (tile); \
        const bf16* kp_ = K + ((size_t)b * SEQ + ((size_t)(kt0_ + r32) << dsh) + res) * 512 + h * 64 + 8 * h2; \
        _Pragma("unroll") for (int s_ = 0; s_ < 4; ++s_) KF[s_] = *(const bf16x8*)(kp_ + 16 * s_); \
        _Pragma("unroll") for (int i_ = 0; i_ < 4; ++i_) { const int id_ = lane + 64 * i_, vr_ = id_ >> 3, vc_ = id_ & 7; \
            VV[i_] = *(const u32x4*)(V + ((size_t)b * SEQ + ((size_t)(kt0_ + vr_) << dsh) + res) * 512 + h * 64 + 8 * vc_); } } while (0)
    ATT_LOAD(kf, vv, j_lo);
    for (int j = j_lo; j < 6; ++j) {
        bf16x8 kn[4]; u32x4 vn[4];
        { const int jn = j < 5 ? j + 1 : 5; ATT_LOAD(kn, vn, jn); }
#pragma unroll
        for (int i = 0; i < 4; ++i) { const int id = lane + 64 * i, vr = id >> 3, vc = id & 7; *(LAS u32x4*)(vl + vr * VRS + vc * 16) = vv[i]; }
        s16x4 t0, t1, t2, t3r, t4, t5, t6, t7;
        asm volatile("s_waitcnt lgkmcnt(0)\n\t"
                     "ds_read_b64_tr_b16 %0, %8\n\tds_read_b64_tr_b16 %1, %8 offset:1152\n\tds_read_b64_tr_b16 %2, %8 offset:2304\n\tds_read_b64_tr_b16 %3, %8 offset:3456\n\t"
                     "ds_read_b64_tr_b16 %4, %8 offset:64\n\tds_read_b64_tr_b16 %5, %8 offset:1216\n\tds_read_b64_tr_b16 %6, %8 offset:2368\n\tds_read_b64_tr_b16 %7, %8 offset:3520\n\t"
                     "s_waitcnt lgkmcnt(0)"
                     : "=&v"(t0), "=&v"(t1), "=&v"(t2), "=&v"(t3r), "=&v"(t4), "=&v"(t5), "=&v"(t6), "=&v"(t7) : "v"(traddr) : "memory");
        const bf16x8 va00 = __builtin_shufflevector(t0, t1, 0, 1, 2, 3, 4, 5, 6, 7), va01 = __builtin_shufflevector(t2, t3r, 0, 1, 2, 3, 4, 5, 6, 7);
        const bf16x8 va10 = __builtin_shufflevector(t4, t5, 0, 1, 2, 3, 4, 5, 6, 7), va11 = __builtin_shufflevector(t6, t7, 0, 1, 2, 3, 4, 5, 6, 7);
        if (j <= 4) attn_qk_pv(kf, qfA, va00, va01, va10, va11, oA0, oA1, mA, lA, j == 0 ? 1 : (j == 4 ? 2 : 0), r32, h2);
        if (j >= 1) attn_qk_pv(kf, qfB, va00, va01, va10, va11, oB0, oB1, mB, lB, j == 1 ? 1 : (j == 5 ? 2 : 0), r32, h2);
#pragma unroll
        for (int i = 0; i < 4; ++i) { kf[i] = kn[i]; vv[i] = vn[i]; }
    }
#undef ATT_LOAD
    attn_store(oA0, oA1, mA, lA, OP, LSE, p, tokA, h, h2);
    attn_store(oB0, oB1, mB, lB, OP, LSE, p, tokB, h, h2);
}

constexpr int HGC_SLOT = 16896, HGC_D = 6, HGC_AM = HGC_D * HGC_SLOT;
constexpr int HG_WGS = 64;
__device__ __forceinline__ void hgrn_coop(int bh, int half, int wave, const bf16* QH, const bf16* KH, const bf16* KOT, const bf16* VT, const float* DEC, bf16* REC, LAS unsigned char* ring, int lane) {
    const int i16 = lane & 15, fq = lane >> 4, b = bh >> 2, h = bh & 3;
    const int gc0 = b * (SEQ / 16);
    if (wave >= 4) {
        const int pw = wave - 4;
        unsigned off[4]; const bf16* src; int dst; int nops;
        if (pw < 2) {
#pragma unroll
            for (int j = 0; j < 4; ++j) { const int P = 64 * j + lane, tok = P >> 4, pcg = (P & 15) ^ (tok & 15); off[j] = (unsigned)(tok * 512 + 128 * h + 8 * pcg); }
            src = pw == 0 ? QH : KH; dst = pw * 4096; nops = 4;
        } else if (pw == 2) {
#pragma unroll
            for (int j = 0; j < 4; ++j) off[j] = (unsigned)(128 * h * 16 + (64 * j + lane) * 8);
            src = KOT; dst = 8192; nops = 4;
        } else {
#pragma unroll
            for (int j = 0; j < 4; ++j) off[j] = (unsigned)((128 * h + 64 * half) * 16 + (64 * (j & 1) + lane) * 8);
            src = VT; dst = 12288; nops = 2;
        }
        const bf16* DECb = (const bf16*)DEC; const unsigned odec = (unsigned)(128 * h + lane * 2);
#define HGC_DMA(gc, slot) do { LAS unsigned char* sb_ = ring + (slot) * HGC_SLOT; const size_t r_ = (size_t)(gc) * (16 * 512); \
            __builtin_amdgcn_global_load_lds((const unsigned*)(src + r_ + off[0]), (LAS unsigned*)(sb_ + dst), 16, 0, 0); \
            __builtin_amdgcn_global_load_lds((const unsigned*)(src + r_ + off[1]), (LAS unsigned*)(sb_ + dst + 1024), 16, 0, 0); \
            if (nops == 4) { __builtin_amdgcn_global_load_lds((const unsigned*)(src + r_ + off[2]), (LAS unsigned*)(sb_ + dst + 2048), 16, 0, 0); \
                             __builtin_amdgcn_global_load_lds((const unsigned*)(src + r_ + off[3]), (LAS unsigned*)(sb_ + dst + 3072), 16, 0, 0); } \
            else { __builtin_amdgcn_global_load_lds((const unsigned*)(DECb + (size_t)(gc) * 512 + odec), (LAS unsigned*)(sb_ + 16384), 4, 0, 0); \
                   __builtin_amdgcn_global_load_lds((const unsigned*)(DECb + (size_t)(gc) * 512 + odec), (LAS unsigned*)(sb_ + 16384), 4, 0, 0); } } while (0)
        HGC_DMA(gc0 + 0, 0); HGC_DMA(gc0 + 1, 1); HGC_DMA(gc0 + 2, 2); HGC_DMA(gc0 + 3, 3); HGC_DMA(gc0 + 4, 4);
        asm volatile("s_waitcnt vmcnt(16)" ::: "memory");
        __builtin_amdgcn_s_barrier();
        int sl = 0;
        for (int c = 0; c < SEQ / 16; ++c) {
            asm volatile("s_waitcnt vmcnt(12)" ::: "memory");
            __builtin_amdgcn_s_barrier();
            asm volatile("" ::: "memory");
            { const int cn = c + 5 < SEQ / 16 ? c + 5 : SEQ / 16 - 1; HGC_DMA(gc0 + cn, sl == 0 ? 5 : sl - 1); }
            sl = sl == 5 ? 0 : sl + 1;
        }
        asm volatile("s_waitcnt vmcnt(0)" ::: "memory");
#undef HGC_DMA
        return;
    }
    const int vs = 4 * half + wave;
    f32x4 S[8];
#pragma unroll
    for (int k = 0; k < 8; ++k) S[k] = (f32x4){0.f, 0.f, 0.f, 0.f};
    unsigned fqk[4];
#pragma unroll
    for (int a = 0; a < 4; ++a) fqk[a] = (unsigned)((i16 * 16 + ((4 * a + fq) ^ i16)) * 16);
    const unsigned fko = (unsigned)(8192 + i16 * 32 + fq * 8), fvt = (unsigned)(12288 + (16 * wave + i16) * 32 + fq * 8), fdc = (unsigned)(16384 + fq * 8);
    const unsigned fam = (unsigned)(HGC_AM + lane * 8);
    const f32x4 z4 = (f32x4){0.f, 0.f, 0.f, 0.f};
#define HGC_SCORES(sl_, buf) do { const LAS unsigned char* sq_ = ring + (sl_) * HGC_SLOT; \
        bf16x8 qa_[4], ka_[4]; \
        _Pragma("unroll") for (int a = 0; a < 4; ++a) { qa_[a] = *(const LAS bf16x8*)(sq_ + fqk[a]); ka_[a] = *(const LAS bf16x8*)(sq_ + 4096 + fqk[a]); } \
        f32x4 p0 = __builtin_amdgcn_mfma_f32_16x16x32_bf16(ka_[0], qa_[0], z4, 0, 0, 0), p1 = __builtin_amdgcn_mfma_f32_16x16x32_bf16(ka_[1], qa_[1], z4, 0, 0, 0); \
        f32x4 p2 = __builtin_amdgcn_mfma_f32_16x16x32_bf16(ka_[2], qa_[2], z4, 0, 0, 0), p3 = __builtin_amdgcn_mfma_f32_16x16x32_bf16(ka_[3], qa_[3], z4, 0, 0, 0); \
        asm volatile("s_nop 7" : "+v"(p0), "+v"(p1), "+v"(p2), "+v"(p3)); \
        f32x4 at = (p0 + p1) + (p2 + p3); \
        _Pragma("unroll") for (int r = 0; r < 4; ++r) if (4 * fq + r > i16) at[r] = 0.f; \
        u32x2 aw; aw.x = pkbf(at[0], at[1]); aw.y = pkbf(at[2], at[3]); \
        *(LAS u32x2*)(ring + fam + (buf) * 512) = aw; } while (0)
    __builtin_amdgcn_s_barrier();
    if (wave == 0) HGC_SCORES(0, 0);
    int sl = 0;
    for (int c = 0; c < SEQ / 16; ++c) {
        asm volatile("s_waitcnt lgkmcnt(0)" ::: "memory");
        __builtin_amdgcn_s_barrier();
        asm volatile("" ::: "memory");
        const int sl1 = sl == 5 ? 0 : sl + 1;
        if (wave == ((c + 1) & 3) && c + 1 < SEQ / 16) HGC_SCORES(sl1, (c + 1) & 1);
        const LAS unsigned char* sb = ring + sl * HGC_SLOT;
        bf16x8 qa[4]; s16x4 ko[8]; u32x2 dc[8];
#pragma unroll
        for (int a = 0; a < 4; ++a) qa[a] = *(const LAS bf16x8*)(sb + fqk[a]);
        const s16x4 vb = *(const LAS s16x4*)(sb + fvt);
        const s16x4 am = *(const LAS s16x4*)(ring + fam + (c & 1) * 512);
#pragma unroll
        for (int k = 0; k < 8; ++k) { ko[k] = *(const LAS s16x4*)(sb + fko + k * 512); dc[k] = *(const LAS u32x2*)(sb + fdc + k * 32); }
        f32x4 oi[4];
#pragma unroll
        for (int a = 0; a < 4; ++a) {
            u32x4 sw; sw.x = pkbf(S[2 * a][0], S[2 * a][1]); sw.y = pkbf(S[2 * a][2], S[2 * a][3]); sw.z = pkbf(S[2 * a + 1][0], S[2 * a + 1][1]); sw.w = pkbf(S[2 * a + 1][2], S[2 * a + 1][3]);
            oi[a] = __builtin_amdgcn_mfma_f32_16x16x32_bf16(qa[a], __builtin_bit_cast(bf16x8, sw), z4, 0, 0, 0);
        }
        f32x4 o = __builtin_amdgcn_mfma_f32_16x16x16bf16_1k(am, vb, z4, 0, 0, 0);
#pragma unroll
        for (int k = 0; k < 8; ++k) { const f32x4 d = (f32x4){bflo(dc[k].x), bfhi(dc[k].x), bflo(dc[k].y), bfhi(dc[k].y)}; S[k] = __builtin_amdgcn_mfma_f32_16x16x16bf16_1k(ko[k], vb, d * S[k], 0, 0, 0); }
        asm volatile("s_nop 7" : "+v"(o), "+v"(oi[0]), "+v"(oi[1]), "+v"(oi[2]), "+v"(oi[3]));
        o = (o + oi[0]) + (oi[1] + oi[2]) + oi[3];
        bf16* rp = REC + ((size_t)(gc0 + c) * 16 + 4 * fq) * 512 + 128 * h + 16 * vs + i16;
        const unsigned w0 = pkbf(o[0], o[1]), w1 = pkbf(o[2], o[3]);
        rp[0] = (bf16)w0; rp[512] = (bf16)(w0 >> 16); rp[1024] = (bf16)w1; rp[1536] = (bf16)(w1 >> 16);
        sl = sl1;
    }
#undef HGC_SCORES
}

__device__ __forceinline__ void combine_row(int row, const bf16* __restrict__ OP, const float* __restrict__ LSE, const bf16* __restrict__ REC, const bf16* __restrict__ GATE, const float* __restrict__ again, const float* __restrict__ hgain, bf16* __restrict__ MIX, int lane) {
    const int hh = lane >> 3;
    float l0 = LSE[((size_t)0 * M + row) * 8 + hh], l1 = LSE[((size_t)1 * M + row) * 8 + hh], l2 = LSE[((size_t)2 * M + row) * 8 + hh];
    const float mx = fmaxf(l0, fmaxf(l1, l2)); l0 = fexp(l0 - mx); l1 = fexp(l1 - mx); l2 = fexp(l2 - mx);
    const float inv = 1.0f / (l0 + l1 + l2); l0 *= inv; l1 *= inv; l2 *= inv;
    const u32x4 a0 = *(const u32x4*)(OP + ((size_t)0 * M + row) * 512 + 8 * lane), a1 = *(const u32x4*)(OP + ((size_t)1 * M + row) * 512 + 8 * lane), a2 = *(const u32x4*)(OP + ((size_t)2 * M + row) * 512 + 8 * lane);
    float v[8]; float s = 0.f;
#pragma unroll
    for (int e = 0; e < 4; ++e) {
        v[2 * e] = l0 * bflo(a0[e]) + l1 * bflo(a1[e]) + l2 * bflo(a2[e]); v[2 * e + 1] = l0 * bfhi(a0[e]) + l1 * bfhi(a1[e]) + l2 * bfhi(a2[e]);
        s += v[2 * e] * v[2 * e] + v[2 * e + 1] * v[2 * e + 1];
    }
    s = wave_sum(s);
    const float ra = __builtin_amdgcn_rsqf(s * (1.0f / 512.0f) + NEPS);
    const f32x4 g0 = *(const f32x4*)(again + 8 * lane), g1 = *(const f32x4*)(again + 8 * lane + 4);
    u32x4 w; w.x = pkbf(v[0] * ra * g0[0], v[1] * ra * g0[1]); w.y = pkbf(v[2] * ra * g0[2], v[3] * ra * g0[3]); w.z = pkbf(v[4] * ra * g1[0], v[5] * ra * g1[1]); w.w = pkbf(v[6] * ra * g1[2], v[7] * ra * g1[3]);
    *(u32x4*)(MIX + (size_t)row * 1024 + 8 * lane) = w;
    const u32x4 r4 = *(const u32x4*)(REC + (size_t)row * 512 + 8 * lane), g4 = *(const u32x4*)(GATE + (size_t)row * 512 + 8 * lane);
    float o[8]; float s2 = 0.f;
#pragma unroll
    for (int e = 0; e < 4; ++e) { o[2 * e] = bflo(r4[e]); o[2 * e + 1] = bfhi(r4[e]); s2 += o[2 * e] * o[2 * e] + o[2 * e + 1] * o[2 * e + 1]; }
    s2 += __shfl_xor(s2, 1); s2 += __shfl_xor(s2, 2); s2 += __shfl_xor(s2, 4); s2 += __shfl_xor(s2, 8);
    const float rh = __builtin_amdgcn_rsqf(s2 * (1.0f / 128.0f) + NEPS);
    const int hc = (8 * lane) & 127;
    const f32x4 h0 = *(const f32x4*)(hgain + hc), h1 = *(const f32x4*)(hgain + hc + 4);
    w.x = pkbf(o[0] * rh * h0[0] * bflo(g4[0]), o[1] * rh * h0[1] * bfhi(g4[0])); w.y = pkbf(o[2] * rh * h0[2] * bflo(g4[1]), o[3] * rh * h0[3] * bfhi(g4[1]));
    w.z = pkbf(o[4] * rh * h1[0] * bflo(g4[2]), o[5] * rh * h1[1] * bfhi(g4[2])); w.w = pkbf(o[6] * rh * h1[2] * bflo(g4[3]), o[7] * rh * h1[3] * bfhi(g4[3]));
    *(u32x4*)(MIX + (size_t)row * 1024 + 512 + 8 * lane) = w;
}

#define XB_TMO      128
#define XB_XCNT(j)  (256  + 64 * (j))
#define XB_XSUB(j)  (1280 + 64 * (j))
#define XB_XGEN(j)  (2304 + 64 * (j))
#define XB_TOP      3328
#define XB_TOPGEN   3392
#define XCD_BAR_WORDS 3456
#define XB_SPIN_CAP (1u << 18)

__device__ __forceinline__ unsigned xb_ld(unsigned* p)              { return __hip_atomic_load(p, __ATOMIC_RELAXED, __HIP_MEMORY_SCOPE_AGENT); }
__device__ __forceinline__ unsigned xb_add(unsigned* p, unsigned v) { return __hip_atomic_fetch_add(p, v, __ATOMIC_RELAXED, __HIP_MEMORY_SCOPE_AGENT); }
__device__ __forceinline__ unsigned xb_xcc_id() { return (unsigned)__builtin_amdgcn_s_getreg((3 << 11) | 20) & 0xFu; }
#define XB_SPIN(cond, bar) do { unsigned _sp = 0; while (cond) { __builtin_amdgcn_s_sleep(1); \
    if ((++_sp & 255u) == 0u) { if (xb_ld(&(bar)[XB_TMO])) break; if (_sp > XB_SPIN_CAP) { atomicAdd(&(bar)[XB_TMO], 1u); break; } } } } while (0)

struct XcdBarrier {
    unsigned* bar; unsigned x;
    volatile LAS unsigned* st;
};

__device__ __forceinline__ XcdBarrier xcd_barrier_post(unsigned* bar, volatile LAS unsigned* st) {
    XcdBarrier b; b.bar = bar; b.x = xb_xcc_id(); b.st = st;
    if (threadIdx.x == 0) (void)xb_add(&bar[XB_XCNT(b.x)], 1u);
    return b;
}
__device__ __forceinline__ void xcd_barrier_complete(unsigned* bar, unsigned x, unsigned& nloc, unsigned& nx) {
    const unsigned G = gridDim.x * gridDim.y * gridDim.z;
    unsigned sum, cnt, mine, sp = 0u;
    for (;;) {
        sum = 0u; cnt = 0u; mine = 0u;
#pragma unroll
        for (unsigned j = 0; j < 16; ++j) { const unsigned c = xb_ld(&bar[XB_XCNT(j)]); sum += c; cnt += (c > 0u) ? 1u : 0u; mine = (j == x) ? c : mine; }
        if (sum == G) break;
        __builtin_amdgcn_s_sleep(1);
        if ((++sp & 255u) == 0u) { if (xb_ld(&bar[XB_TMO])) break; if (sp > XB_SPIN_CAP) { atomicAdd(&bar[XB_TMO], 1u); break; } }
    }
    nloc = mine > 0u ? mine : 1u; nx = cnt > 0u ? cnt : 1u;
}

__device__ __forceinline__ void xcd_barrier(const XcdBarrier& b) {
    asm volatile("s_waitcnt vmcnt(0)" ::: "memory");
    __syncthreads();
    if (threadIdx.x == 0) {
        unsigned* bar = b.bar;
        __builtin_amdgcn_s_waitcnt(0);
        unsigned nloc = b.st[0], nx = b.st[1];
        if (nloc == 0u) { xcd_barrier_complete(bar, b.x, nloc, nx); b.st[0] = nloc; b.st[1] = nx; }
        const unsigned old = xb_add(&bar[XB_XSUB(b.x)], 1u);
        const unsigned gen = old / nloc;
        if (old + 1u == (gen + 1u) * nloc) {
            __builtin_amdgcn_fence(__ATOMIC_RELEASE, "agent");
            asm volatile("s_waitcnt vmcnt(0)" ::: "memory");
            const unsigned og = xb_add(&bar[XB_TOP], 1u);
            const unsigned tg = og / nx;
            if (og + 1u == (tg + 1u) * nx) xb_add(&bar[XB_TOPGEN], 1u);
            else XB_SPIN(xb_ld(&bar[XB_TOPGEN]) == tg, bar);
            __builtin_amdgcn_fence(__ATOMIC_ACQUIRE, "agent");
            xb_add(&bar[XB_XGEN(b.x)], 1u);
            asm volatile("s_waitcnt vmcnt(0)" ::: "memory");
        } else {
            XB_SPIN(xb_ld(&bar[XB_XGEN(b.x)]) == gen, bar);
            __builtin_amdgcn_fence(__ATOMIC_ACQUIRE, "agent");
            asm volatile("s_waitcnt vmcnt(0)" ::: "memory");
        }
    }
    __syncthreads();
}

#ifndef EPI_SKIP
#define EPI_SKIP 0
#endif
#ifndef DBG_MASK
#define DBG_MASK 63
#endif
constexpr int N_PHASES = 14;

template <int PH>
__device__ __forceinline__ void run_phase(const Args& A, LAS unsigned char* lds, const int wave) {
    const int G = gridDim.x;
    const int lane = (int)__builtin_amdgcn_mbcnt_hi(~0u, __builtin_amdgcn_mbcnt_lo(~0u, 0u));
    unsigned char* ws = A.ws;
    if constexpr (PH == 0) {
        p0_prologue(A, lds, wave, lane);
    } else if constexpr (PH == N_PHASES - 1) {
        float* X = A.out; const float* ssf = (const float*)(ws + WS_SS) + 4 * (size_t)M; const float* gn = A.in[10];
        const f32x4 g0 = *((const f32x4*)gn + lane), g1 = *((const f32x4*)gn + lane + 64), g2 = *((const f32x4*)gn + lane + 128), g3 = *((const f32x4*)gn + lane + 192);
        for (int m = blockIdx.x * NWAVES + wave; m < M; m += 4 * G * NWAVES) {
            const int st = G * NWAVES;
            float r[4]; f32x4 v[4][4];
#pragma unroll
            for (int q = 0; q < 4; ++q) {
                r[q] = __builtin_amdgcn_rsqf(ssf[m + q * st] * (1.0f / 1024.0f) + NEPS);
                const f32x4* xr = (const f32x4*)(X + (size_t)(m + q * st) * D) + lane;
#pragma unroll
                for (int j = 0; j < 4; ++j) v[q][j] = xr[64 * j];
            }
#pragma unroll
            for (int q = 0; q < 4; ++q) {
                f32x4* xr = (f32x4*)(X + (size_t)(m + q * st) * D) + lane;
                xr[0] = v[q][0] * r[q] * g0; xr[64] = v[q][1] * r[q] * g1; xr[128] = v[q][2] * r[q] * g2; xr[192] = v[q][3] * r[q] * g3;
            }
        }
    } else {
        constexpr int l = (PH - 1) / 6, sp = (PH - 1) % 6;
        float* SS = (float*)(ws + WS_SS);
        if constexpr (sp == 0) {
            const float* ss_in = l == 0 ? SS : SS + 2 * (size_t)M;
            pg8::Gemm g{(const bf16*)(ws + WS_XB), (const bf16*)(ws + WS_WIN) + (size_t)l * NIN * D, M, NIN, D}; pg8::StaticOrder S; S.init(M, NIN, G, (int)blockIdx.x, 4);
            pg8::EpiIn E{ss_in, (const float*)(ws + WS_ROPE), A.in[4], l, ws + WS_A, (float*)(ws + WS_DEC)};
            pg8::gemm_phase<pg8::EpiIn, pg8::StaticOrder, true, true>(lds, g, S, E, wave);
        } else if constexpr (sp == 1) {
            bf16 *Qb = (bf16*)(ws + WS_A), *Kb = (bf16*)(ws + WS_A + 32 * MiB), *Vb = (bf16*)(ws + WS_A + 64 * MiB), *QH = (bf16*)(ws + WS_A + 96 * MiB), *KH = (bf16*)(ws + WS_A + 128 * MiB),
                 *KOT = (bf16*)(ws + WS_A + 160 * MiB), *VT = (bf16*)(ws + WS_A + 192 * MiB);
            if (G > 2 * HG_WGS) {
                if ((int)blockIdx.x < HG_WGS) {
                    hgrn_coop((int)blockIdx.x >> 1, (int)blockIdx.x & 1, wave, QH, KH, KOT, VT, (const float*)(ws + WS_DEC), (bf16*)(ws + WS_REC), lds, lane);
                } else {
                    LAS unsigned char* vl = lds + wave * (32 * VRS);
                    for (int it = ((int)blockIdx.x - HG_WGS) * 8 + wave; it < ATT_ITEMS; it += (G - HG_WGS) * 8) attn_item(it, Qb, Kb, Vb, (bf16*)(ws + WS_OP), (float*)(ws + WS_LSE), vl, lane);
                }
            }
        } else if constexpr (sp == 2) {
            const float* again = A.in[3] + l * 512; const float* hgain = A.in[5] + l * 128;
            for (int m = blockIdx.x * NWAVES + wave; m < M; m += 2 * G * NWAVES) {
                combine_row(m, (const bf16*)(ws + WS_OP), (const float*)(ws + WS_LSE), (const bf16*)(ws + WS_REC), (const bf16*)(ws + WS_A + 224 * MiB), again, hgain, (bf16*)(ws + WS_A), lane);
                combine_row(m + G * NWAVES, (const bf16*)(ws + WS_OP), (const float*)(ws + WS_LSE), (const bf16*)(ws + WS_REC), (const bf16*)(ws + WS_A + 224 * MiB), again, hgain, (bf16*)(ws + WS_A), lane);
            }
        } else if constexpr (sp == 3) {
            pg8::Gemm g{(const bf16*)(ws + WS_A), (const bf16*)(ws + WS_WOUT) + (size_t)l * D * D, M, D, D}; pg8::StaticOrder S; S.init(M, D, G, (int)blockIdx.x, 4);
            pg8::EpiRes E{l == 0 ? A.in[0] : A.out, A.out, (bf16*)(ws + WS_XB), SS + (size_t)(1 + 2 * l) * M};
            pg8::gemm_phase<pg8::EpiRes, pg8::StaticOrder, true, true>(lds, g, S, E, wave);
        } else if constexpr (sp == 4) {
            pg8::Gemm g{(const bf16*)(ws + WS_XB), (const bf16*)(ws + WS_WUP) + (size_t)l * FF * D, M, FF, D}; pg8::StaticOrder S; S.init(M, FF, G, (int)blockIdx.x);
            pg8::EpiUp E{SS + (size_t)(1 + 2 * l) * M, (bf16*)(ws + WS_A)};
            pg8::gemm_phase<pg8::EpiUp, pg8::StaticOrder, true, true>(lds, g, S, E, wave);
        } else {
            pg8::Gemm g{(const bf16*)(ws + WS_A), (const bf16*)(ws + WS_WDN) + (size_t)l * D * FF, M, D, FF}; pg8::StaticOrder S; S.init(M, D, G, (int)blockIdx.x, 4);
            pg8::EpiRes E{A.out, A.out, l + 1 < NLAYER ? (bf16*)(ws + WS_XB) : nullptr, SS + (size_t)(2 + 2 * l) * M};
            pg8::gemm_phase<pg8::EpiRes, pg8::StaticOrder, true, true>(lds, g, S, E, wave);
        }
    }
}

__global__ void __launch_bounds__(NWAVES * 64, 2) hymba_fwd(Args A) {
    extern __shared__ __attribute__((aligned(16))) unsigned char lds_raw[];
    LAS unsigned char* lds = (LAS unsigned char*)lds_raw;
    const int wave = __builtin_amdgcn_readfirstlane((int)threadIdx.x >> 6);
    cg::grid_group grid = cg::this_grid();
    const int lo = A.ph_lo, hi = A.ph_hi;
    volatile LAS unsigned* bst = (volatile LAS unsigned*)(lds + LDS_BYTES - 64);
    if (threadIdx.x == 0) { bst[0] = 0u; bst[1] = 0u; }
    __syncthreads();
    const XcdBarrier xbar = xcd_barrier_post((unsigned*)(A.ws + WS_BAR), bst);
    if (hi == 0x7fffffff) grid.sync();
#define PHASE(k) if (lo <= (k) && (k) < hi) { run_phase<k>(A, lds, wave); if ((k) + 1 < hi) xcd_barrier(xbar); }
    PHASE(0) PHASE(1) PHASE(2) PHASE(3) PHASE(4) PHASE(5) PHASE(6) PHASE(7) PHASE(8) PHASE(9) PHASE(10) PHASE(11) PHASE(12) PHASE(13)
#undef PHASE
}

extern "C" void kernel_launch(void* const* d_in, const int* in_sizes, int n_in, void* d_out, int out_size, void* d_ws, size_t ws_size, hipStream_t stream) {
    static int grid = 0;
    if (grid == 0) {
        if (n_in != 11 || in_sizes[0] != M * D || out_size != M * D || ws_size < WS_END) { fprintf(stderr, "kernel_launch: unexpected shapes (n_in %d, in0 %d, out %d, ws %zu)\n", n_in, n_in > 0 ? in_sizes[0] : -1, out_size, ws_size); grid = -1; return; }
        int dev = 0, cus = 0, per_cu = 0;
        if (hipGetDevice(&dev) != hipSuccess || hipDeviceGetAttribute(&cus, hipDeviceAttributeMultiprocessorCount, dev) != hipSuccess) { grid = -1; return; }
        if (hipFuncSetAttribute((const void*)hymba_fwd, hipFuncAttributeMaxDynamicSharedMemorySize, LDS_BYTES) != hipSuccess) { fprintf(stderr, "kernel_launch: hipFuncSetAttribute failed\n"); grid = -1; return; }
        if (hipOccupancyMaxActiveBlocksPerMultiprocessor(&per_cu, (const void*)hymba_fwd, NWAVES * 64, LDS_BYTES) != hipSuccess || per_cu < 1) { fprintf(stderr, "kernel_launch: occupancy query says %d\n", per_cu); per_cu = 1; }
        (void)hipGetLastError();
        grid = cus * 1;
    }
    if (grid < 0) return;
    Args a{};
    for (int i = 0; i < 11; ++i) a.in[i] = (const float*)d_in[i];
    a.out = (float*)d_out; a.ws = (unsigned char*)d_ws;
    for (int i = 0; i < 32; ++i) a.inv_freq[i] = (float)pow(10000.0, -(double)i / 32.0);
#if N_LAUNCH_MODE == 1
    if (hipMemsetAsync((char*)d_ws + WS_BAR, 0, 16384, stream) != hipSuccess) { fprintf(stderr, "kernel_launch: memset of the barrier words failed\n"); return; }
    a.ph_lo = 0; a.ph_hi = N_PHASES;
    void* args[] = {&a};
    hipError_t e = hipLaunchCooperativeKernel((const void*)hymba_fwd, dim3(grid), dim3(NWAVES * 64), args, LDS_BYTES, stream);
    if (e != hipSuccess) fprintf(stderr, "cooperative launch failed: %s (grid %d)\n", hipGetErrorString(e), grid);
#else
    for (int ph = 0; ph < N_PHASES; ++ph) {
        a.ph_lo = ph; a.ph_hi = ph + 1;
        hipLaunchKernelGGL(hymba_fwd, dim3(grid), dim3(NWAVES * 64), LDS_BYTES, stream, a);
    }
#endif
}
```

```cpp
#include <hip/hip_runtime.h>
#include <hip/hip_cooperative_groups.h>
#include <cstdio>
#include <cstdint>
#include <cmath>
namespace cg = cooperative_groups;
#ifndef EPI_SKIP
#define EPI_SKIP 0
#endif

namespace pg8 {
#define PG8_LAS __attribute__((address_space(3)))
typedef unsigned short bf16_t;
typedef short bf16x8 __attribute__((ext_vector_type(8)));
typedef float f32x4 __attribute__((ext_vector_type(4)));
typedef unsigned u32x4 __attribute__((ext_vector_type(4)));
constexpr int BM = 256, BK = 64, HALF = 128, HTB = HALF * BK * 2  , STAGE_BYTES = 8 * HTB, NXCD = 8, WGM = 8;

__host__ __device__ __forceinline__ int lds_byte(int r, int c) { const int st = (r >> 4) * 2 + (c >> 5), rr = r & 15, cc = c & 31, ob = rr * 64 + cc * 2; return st * 1024 + (ob ^ (((ob >> 9) & 1) << 5)); }
__host__ __device__ __forceinline__ void stage_rc(int b, int& R, int& C) { const int st = b / 1024, sb = b % 1024, swz = sb ^ (((sb >> 9) & 1) << 5); R = (st >> 1) * 16 + swz / 64; C = (st & 1) * 32 + (swz % 64) / 2; }
__host__ __device__ __forceinline__ int perm32(int rho) { const int n = rho >> 4, i = rho & 15; return 8 * (i >> 2) + 4 * n + (i & 3); }

struct Unit { int pm, pn; };
struct Gemm { const bf16_t* A; const bf16_t* Bt; int M, N, K; };

struct StaticOrder {
    int nM, nN, nwg, G, c, wgm;
    __host__ __device__ void init(int M, int N, int G_, int c_, int wgm_ = 8) { nM = M / BM; nN = N / BM; nwg = nM * nN; G = G_; c = c_; wgm = wgm_; }
    __host__ __device__ bool next(int i, Unit& u) const {
        const long L = (long)i * G + c; if (L >= nwg) return false;
        int wgid = (int)L; { const int q = nwg / NXCD, r = nwg % NXCD, xcd = wgid % NXCD, off = wgid / NXCD; wgid = (xcd < r ? xcd * (q + 1) : r * (q + 1) + (xcd - r) * q) + off; }
        const int nig = wgm * nN, gid = wgid / nig, fm = gid * wgm, gsz = (nM - fm) < wgm ? (nM - fm) : wgm;
        u.pm = fm + ((wgid % nig) % gsz); u.pn = (wgid % nig) / gsz; return true;
    }
    __device__ __forceinline__ void a_ready(const Unit&) const {}
    __device__ __forceinline__ void done(const Unit&) const {}
};

__device__ __forceinline__ unsigned cvt_pk_bf16(float lo, float hi) { unsigned r; asm volatile("v_cvt_pk_bf16_f32 %0, %1, %2" : "=v"(r) : "v"(lo), "v"(hi)); return r; }
template <class Epi, class Sched, bool ALIGN_EPI = false, bool SP2 = false>
__device__ __forceinline__ void gemm_phase(PG8_LAS unsigned char* lds, const Gemm g, const Sched& S, const Epi& E, const int wid) {
    const int lane = (int)__builtin_amdgcn_mbcnt_hi(~0u, __builtin_amdgcn_mbcnt_lo(~0u, 0u)), tid = wid * 64 + lane, wr = wid >> 2, wc = wid & 3, fr = lane & 15, fq = lane >> 4;
    const int K = g.K, nt = K / BK;
    unsigned voffA[2], voffB[2];
#pragma unroll
    for (int i = 0; i < 2; ++i) { int R, C; stage_rc(tid * 16 + i * 8192, R, C); const int Rb = Epi::PERM ? ((R & ~31) + perm32(R & 31)) : R;
        voffA[i] = (unsigned)(R * K + C) * 2u; voffB[i] = (unsigned)(Rb * K + C) * 2u; }
    const size_t kstep = (size_t)(BK * 2);
    const size_t hstep = (size_t)HALF * K * 2;
    const size_t tstep = 2 * hstep;
    const unsigned ldsw = (unsigned)wid * 1024u;
    const int aoff = lds_byte(wr * 64 + fr, fq * 8), boff = lds_byte(wc * 32 + fr, fq * 8);
#define PG8_SA(b, h) (((b) * 2 + (h)) * HTB)
#define PG8_SB(b, h) ((4 + (b) * 2 + (h)) * HTB)
#define PG8_STAGE(bufoff, gbase, voff) do { _Pragma("unroll") for (int _i = 0; _i < 2; ++_i) \
        __builtin_amdgcn_global_load_lds((const unsigned*)((const char*)(gbase) + (voff)[_i]), (PG8_LAS unsigned*)(lds + (bufoff) + ldsw + _i * 8192), 16, 0, 0); } while (0)
#define PG8_LDA(dst, b, h) do { _Pragma("unroll") for (int m = 0; m < 4; ++m) _Pragma("unroll") for (int k = 0; k < 2; ++k) dst[m][k] = *(const PG8_LAS bf16x8*)(lds + PG8_SA(b, h) + aoff + m * 2048 + k * 1024); } while (0)
#define PG8_LDB(dst, b, h) do { _Pragma("unroll") for (int n = 0; n < 2; ++n) _Pragma("unroll") for (int k = 0; k < 2; ++k) dst[n][k] = *(const PG8_LAS bf16x8*)(lds + PG8_SB(b, h) + boff + n * 2048 + k * 1024); } while (0)
#define PG8_MMA(ai, bj, At, Bt) do { __builtin_amdgcn_s_setprio(1); _Pragma("unroll") for (int m = 0; m < 4; ++m) _Pragma("unroll") for (int n = 0; n < 2; ++n) _Pragma("unroll") for (int k = 0; k < 2; ++k) \
        acc[ai][bj][m][n] = __builtin_amdgcn_mfma_f32_16x16x32_bf16(Bt[n][k], At[m][k], acc[ai][bj][m][n], 0, 0, 0); __builtin_amdgcn_s_setprio(0); } while (0)
#define PG8_WAIT_V(n) asm volatile("s_waitcnt vmcnt(" #n ")" ::: "memory")
#define PG8_WAIT_L(n) asm volatile("s_waitcnt lgkmcnt(" #n ")" ::: "memory")
#define PG8_BAR __builtin_amdgcn_s_barrier()
#define PG8_SCHED __builtin_amdgcn_sched_barrier(0)
    Unit cur, nxt; int ui = 0;
    if (!S.next(0, cur)) return;
    f32x4 acc[2][2][4][2];
#pragma unroll
    for (int a = 0; a < 2; ++a)
#pragma unroll
        for (int b = 0; b < 2; ++b)
#pragma unroll
            for (int m = 0; m < 4; ++m)
#pragma unroll
                for (int n = 0; n < 2; ++n) acc[a][b][m][n] = (f32x4){0.f, 0.f, 0.f, 0.f};
    bf16x8 At[4][2], B0[2][2], B1[2][2];
    const char* cA = (const char*)g.A + (size_t)cur.pm * tstep; const char* cB = (const char*)g.Bt + (size_t)cur.pn * tstep;
    S.a_ready(cur);
    if constexpr (SP2) {
        PG8_STAGE(PG8_SB(0, 0), cB, voffB); PG8_STAGE(PG8_SB(0, 1), cB + hstep, voffB); PG8_STAGE(PG8_SA(0, 0), cA, voffA); PG8_STAGE(PG8_SA(0, 1), cA + hstep, voffA);
        if (wr == 1) PG8_BAR;
        PG8_WAIT_V(2); PG8_BAR;
        PG8_STAGE(PG8_SB(1, 0), cB + kstep, voffB); PG8_STAGE(PG8_SA(1, 0), cA + kstep, voffA); PG8_STAGE(PG8_SB(1, 1), cB + hstep + kstep, voffB);
        PG8_WAIT_V(6); PG8_BAR;
    } else {
        PG8_STAGE(PG8_SB(0, 0), cB, voffB); PG8_STAGE(PG8_SA(0, 0), cA, voffA); PG8_STAGE(PG8_SB(0, 1), cB + hstep, voffB); PG8_STAGE(PG8_SA(0, 1), cA + hstep, voffA);
        if (wr == 1) PG8_BAR;
        PG8_WAIT_V(4); PG8_BAR;
        PG8_STAGE(PG8_SB(1, 0), cB + kstep, voffB); PG8_STAGE(PG8_SA(1, 0), cA + kstep, voffA); PG8_STAGE(PG8_SB(1, 1), cB + hstep + kstep, voffB);
        PG8_WAIT_V(6); PG8_BAR;
    }
    for (;;) {
        const bool has_next = S.next(ui + 1, nxt);
        const char* nA = has_next ? (const char*)g.A + (size_t)nxt.pm * tstep : cA; const char* nB = has_next ? (const char*)g.Bt + (size_t)nxt.pn * tstep : cB;
        for (int t = 0; t < nt; t += 2) {
            const bool last = (t == nt - 2);
            const char* a1 = cA + (size_t)(t + 1) * kstep;
            const char* a2 = last ? nA : cA + (size_t)(t + 2) * kstep; const char* b2 = last ? nB : cB + (size_t)(t + 2) * kstep;
            const char* a3 = a2 + kstep; const char* b3 = b2 + kstep;
            if (last && has_next) S.a_ready(nxt);
            if constexpr (SP2) {
            PG8_LDB(B0, 0, 0); PG8_LDB(B1, 0, 1); PG8_SCHED; PG8_LDA(At, 0, 0); PG8_STAGE(PG8_SA(1, 1), a1 + hstep, voffA);
            PG8_WAIT_V(8); PG8_WAIT_L(0); PG8_BAR; PG8_MMA(0, 0, At, B0); PG8_MMA(0, 1, At, B1); PG8_BAR; PG8_SCHED;
            PG8_LDA(At, 0, 1); PG8_STAGE(PG8_SB(0, 0), b2, voffB); PG8_STAGE(PG8_SB(0, 1), b2 + hstep, voffB); PG8_STAGE(PG8_SA(0, 0), a2, voffA);
            PG8_WAIT_V(8); PG8_WAIT_L(0); PG8_BAR; PG8_MMA(1, 0, At, B0); PG8_MMA(1, 1, At, B1); PG8_BAR; PG8_SCHED;
            PG8_LDB(B0, 1, 0); PG8_LDB(B1, 1, 1); PG8_SCHED; PG8_LDA(At, 1, 0); PG8_STAGE(PG8_SA(0, 1), a2 + hstep, voffA);
            PG8_WAIT_V(8); PG8_WAIT_L(0); PG8_BAR; PG8_MMA(0, 0, At, B0); PG8_MMA(0, 1, At, B1); PG8_BAR; PG8_SCHED;
            PG8_LDA(At, 1, 1); PG8_STAGE(PG8_SB(1, 0), b3, voffB); PG8_STAGE(PG8_SB(1, 1), b3 + hstep, voffB); PG8_STAGE(PG8_SA(1, 0), a3, voffA);
            PG8_WAIT_V(8); PG8_WAIT_L(0); PG8_BAR; PG8_MMA(1, 0, At, B0); PG8_MMA(1, 1, At, B1); PG8_BAR; PG8_SCHED;
            } else {
            PG8_LDB(B0, 0, 0); PG8_SCHED; PG8_LDA(At, 0, 0); PG8_STAGE(PG8_SA(1, 1), a1 + hstep, voffA);
            PG8_WAIT_L(8); PG8_BAR; PG8_WAIT_L(0); PG8_MMA(0, 0, At, B0); PG8_BAR; PG8_SCHED;
            PG8_LDB(B1, 0, 1); PG8_STAGE(PG8_SB(0, 0), b2, voffB);
            PG8_BAR; PG8_WAIT_L(0); PG8_MMA(0, 1, At, B1); PG8_BAR;
            PG8_LDA(At, 0, 1); PG8_STAGE(PG8_SA(0, 0), a2, voffA);
            PG8_BAR; PG8_WAIT_L(0); PG8_MMA(1, 0, At, B0); PG8_BAR; PG8_SCHED;
            PG8_STAGE(PG8_SB(0, 1), b2 + hstep, voffB);
            PG8_WAIT_V(6); PG8_BAR; PG8_MMA(1, 1, At, B1); PG8_BAR;
            PG8_LDB(B0, 1, 0); PG8_SCHED; PG8_LDA(At, 1, 0); PG8_STAGE(PG8_SA(0, 1), a2 + hstep, voffA);
            PG8_WAIT_L(8); PG8_BAR; PG8_WAIT_L(0); PG8_MMA(0, 0, At, B0); PG8_BAR; PG8_SCHED;
            PG8_LDB(B1, 1, 1); PG8_STAGE(PG8_SB(1, 0), b3, voffB);
            PG8_BAR; PG8_WAIT_L(0); PG8_MMA(0, 1, At, B1); PG8_BAR;
            PG8_LDA(At, 1, 1); PG8_STAGE(PG8_SA(1, 0), a3, voffA);
            PG8_BAR; PG8_WAIT_L(0); PG8_MMA(1, 0, At, B0); PG8_BAR; PG8_SCHED;
            PG8_STAGE(PG8_SB(1, 1), b3 + hstep, voffB);
            PG8_WAIT_V(6); PG8_BAR; PG8_MMA(1, 1, At, B1); PG8_BAR;
            }
        }
        if constexpr (ALIGN_EPI) { if (wr == 0) PG8_BAR; }
        if constexpr (!Epi::AFTER_DRAIN) { E(acc, cur, wr, wc, fr, fq); S.done(cur); }
        if (!has_next) break;
#pragma unroll
        for (int a = 0; a < 2; ++a)
#pragma unroll
            for (int b = 0; b < 2; ++b)
#pragma unroll
                for (int m = 0; m < 4; ++m)
#pragma unroll
                    for (int n = 0; n < 2; ++n) acc[a][b][m][n] = (f32x4){0.f, 0.f, 0.f, 0.f};
        cur = nxt; cA = nA; cB = nB; ++ui;
        if constexpr (ALIGN_EPI) { if (wr == 1) PG8_BAR; }
    }
    PG8_WAIT_V(0);
    if constexpr (!ALIGN_EPI) { if (wr == 0) PG8_BAR; }
    PG8_BAR;
    if constexpr (Epi::AFTER_DRAIN) { E.fused(acc, cur, wr, wc, fr, fq, lds, wid, lane); S.done(cur); }
#undef PG8_SA
#undef PG8_SB
#undef PG8_STAGE
#undef PG8_LDA
#undef PG8_LDB
#undef PG8_MMA
#undef PG8_WAIT_V
#undef PG8_WAIT_L
#undef PG8_BAR
#undef PG8_SCHED
}
}


constexpr int NB = 8, SEQ = 4096, D = 1024, M = NB * SEQ, NIN = 3584, FF = 4096, NLAYER = 2;
constexpr int NWAVES = 8;
constexpr float NEPS = 1e-6f;
#ifndef N_LAUNCH_MODE
#define N_LAUNCH_MODE 1
#endif

constexpr size_t MiB = 1u << 20;
constexpr size_t WS_SS = 0;
constexpr size_t WS_BAR = 768 * 1024;
constexpr size_t WS_ROPE = 1 * MiB;
constexpr size_t WS_WIN = 2 * MiB;
constexpr size_t WS_WOUT = 16 * MiB;
constexpr size_t WS_WUP = 20 * MiB;
constexpr size_t WS_WDN = 36 * MiB;
constexpr size_t WS_XB = 52 * MiB;
constexpr size_t WS_A = 116 * MiB;
constexpr size_t WS_OP = 372 * MiB;
constexpr size_t WS_REC = 468 * MiB;
constexpr size_t WS_LSE = 500 * MiB;
constexpr size_t WS_DEC = 503 * MiB;
constexpr size_t WS_END = 507 * MiB;

constexpr int LDS_BYTES = 147456;

#define LAS __attribute__((address_space(3)))
typedef unsigned short bf16;
typedef unsigned u32x4 __attribute__((ext_vector_type(4)));
typedef unsigned u32x2 __attribute__((ext_vector_type(2)));
typedef float f32x4 __attribute__((ext_vector_type(4)));
typedef float f32x2 __attribute__((ext_vector_type(2)));
typedef float f32x16 __attribute__((ext_vector_type(16)));
typedef short bf16x8 __attribute__((ext_vector_type(8)));
typedef short s16x4 __attribute__((ext_vector_type(4)));
typedef __bf16 nbf2 __attribute__((ext_vector_type(2)));

__device__ __forceinline__ unsigned pkbf(float lo, float hi) { f32x2 v = {lo, hi}; nbf2 r = __builtin_convertvector(v, nbf2); return __builtin_bit_cast(unsigned, r); }
__device__ __forceinline__ float bflo(unsigned u) { return __uint_as_float(u << 16); }
__device__ __forceinline__ float bfhi(unsigned u) { return __uint_as_float(u & 0xffff0000u); }
__device__ __forceinline__ float fexp(float x) { return __builtin_amdgcn_exp2f(x * 1.4426950408889634f); }
__device__ __forceinline__ float frcp(float x) { return __builtin_amdgcn_rcpf(x); }
__device__ __forceinline__ float flog(float x) { return __builtin_amdgcn_logf(x) * 0.6931471805599453f; }
template <int N> __device__ __forceinline__ float row_shr(float v) { return __int_as_float(__builtin_amdgcn_update_dpp(0, __float_as_int(v), 0x110 + N, 0xf, 0xf, true)); }

namespace pg8 {
struct EpiIn {
    static constexpr bool PERM = true, AFTER_DRAIN = false;
    const float* ss; const float* rope; const float* lbl; int layer;
    unsigned char* wa; float* DEC;
    __device__ __forceinline__ void operator()(const f32x4 (&acc)[2][2][4][2], const Unit& u, int wr, int wc, int fr, int fq) const {
        asm volatile("" : "+v"(fr), "+v"(fq));
        const int row0 = u.pm * BM + wr * 64 + fr;
#define RS_AT(ai, m) __builtin_amdgcn_rsqf(ss[row0 + (ai) * HALF + (m) * 16] * (1.0f / 1024.0f) + 1e-6f)
        const int pn = u.pn;
        bf16_t *Q = (bf16_t*)wa, *K = (bf16_t*)(wa + (32u << 20)), *V = (bf16_t*)(wa + (64u << 20)), *QH = (bf16_t*)(wa + (96u << 20)), *KH = (bf16_t*)(wa + (128u << 20)),
               *KOT = (bf16_t*)(wa + (160u << 20)), *VT = (bf16_t*)(wa + (192u << 20)), *GATE = (bf16_t*)(wa + (224u << 20));
        if (pn < 4 && !(EPI_SKIP & 1)) {
            bf16_t* base = (pn >> 1) ? K : Q; const float sc = (pn >> 1) ? 1.0f : 0.125f;
            const int colt = (pn & 1) * 256 + wc * 32 + 8 * fq, i0 = 16 * (wc & 1) + 4 * fq;
#pragma unroll
            for (int ai = 0; ai < 2; ++ai)
#pragma unroll
                for (int m = 0; m < 4; ++m) {
                    const int row = row0 + ai * HALF + m * 16, pos = row & (4096 - 1);
                    const f32x4* rp = (const f32x4*)(rope + (size_t)(pos * 32 + i0) * 2);
                    const f32x4 c0 = rp[0], c1 = rp[1]; const float r = RS_AT(ai, m) * sc;
#pragma unroll
                    for (int bj = 0; bj < 2; ++bj) {
                        const f32x4 a = acc[ai][bj][m][0] * r, b = acc[ai][bj][m][1] * r; u32x4 w;
                        w.x = cvt_pk_bf16(a[0] * c0[0] - a[1] * c0[1], a[0] * c0[1] + a[1] * c0[0]);
                        w.y = cvt_pk_bf16(a[2] * c0[2] - a[3] * c0[3], a[2] * c0[3] + a[3] * c0[2]);
                        w.z = cvt_pk_bf16(b[0] * c1[0] - b[1] * c1[1], b[0] * c1[1] + b[1] * c1[0]);
                        w.w = cvt_pk_bf16(b[2] * c1[2] - b[3] * c1[3], b[2] * c1[3] + b[3] * c1[2]);
                        *(u32x4*)(base + (size_t)row * 512 + colt + bj * HALF) = w;
                    }
                }
        } else if ((pn < 6 || pn >= 12) && !(EPI_SKIP & 2)) {
            const bool gate = pn >= 12; bf16_t* base = gate ? GATE : V;
            const int colt = ((pn - (gate ? 12 : 4)) & 1) * 256 + wc * 32 + 8 * fq;
#pragma unroll
            for (int ai = 0; ai < 2; ++ai)
#pragma unroll
                for (int m = 0; m < 4; ++m) {
                    const int row = row0 + ai * HALF + m * 16; const float r = RS_AT(ai, m);
#pragma unroll
                    for (int bj = 0; bj < 2; ++bj) {
                        f32x4 a = acc[ai][bj][m][0] * r, b = acc[ai][bj][m][1] * r;
                        if (gate) {
#pragma unroll
                            for (int e = 0; e < 4; ++e) { a[e] = a[e] * frcp(1.0f + fexp(-a[e])); b[e] = b[e] * frcp(1.0f + fexp(-b[e])); }
                        }
                        u32x4 w; w.x = cvt_pk_bf16(a[0], a[1]); w.y = cvt_pk_bf16(a[2], a[3]); w.z = cvt_pk_bf16(b[0], b[1]); w.w = cvt_pk_bf16(b[2], b[3]);
                        *(u32x4*)(base + (size_t)row * 512 + colt + bj * HALF) = w;
                    }
                }
        } else if (pn >= 10 && !(EPI_SKIP & 4)) {
            const int c0 = (pn - 10) * 256 + wc * 32 + 8 * fq;
#pragma unroll
            for (int ai = 0; ai < 2; ++ai)
#pragma unroll
                for (int m = 0; m < 4; ++m) {
                    const int rowb = u.pm * BM + wr * 64 + ai * HALF + m * 16, chunk = rowb >> 4; const float r = RS_AT(ai, m);
#pragma unroll
                    for (int bj = 0; bj < 2; ++bj) {
                        const f32x4 a = acc[ai][bj][m][0] * r, b = acc[ai][bj][m][1] * r;
                        bf16_t* p = VT + ((size_t)chunk * 512 + c0 + bj * HALF) * 16 + fr;
                        const unsigned w0 = cvt_pk_bf16(a[0], a[1]), w1 = cvt_pk_bf16(a[2], a[3]), w2 = cvt_pk_bf16(b[0], b[1]), w3 = cvt_pk_bf16(b[2], b[3]);
                        p[0] = (bf16_t)w0; p[16] = (bf16_t)(w0 >> 16); p[32] = (bf16_t)w1; p[48] = (bf16_t)(w1 >> 16);
                        p[64] = (bf16_t)w2; p[80] = (bf16_t)(w2 >> 16); p[96] = (bf16_t)w3; p[112] = (bf16_t)(w3 >> 16);
                    }
                }
        } else if (!(EPI_SKIP & 8)) {
            const int hd = pn - 6;
#pragma unroll
            for (int bj = 0; bj < 2; ++bj) {
                const int ch = 128 * hd + 64 * bj + 16 * wc + 4 * fq;
                const int chp = 128 * hd + 8 * (4 * (2 * bj + (wc >> 1)) + fq) + 4 * (wc & 1);
                float lb[4];
#pragma unroll
                for (int e = 0; e < 4; ++e) lb[e] = layer == 0 ? 0.0f : frcp(1.0f + fexp(lbl[ch + e] - lbl[512 + ch + e]));
#pragma unroll
                for (int ai = 0; ai < 2; ++ai)
#pragma unroll
                    for (int m = 0; m < 4; ++m) {
                        const int rowb = u.pm * BM + wr * 64 + ai * HALF + m * 16, row = rowb + fr, chunk = rowb >> 4; const float r = RS_AT(ai, m);
                        const f32x4 qv = acc[ai][bj][m][0] * r, zv = acc[ai][bj][m][1] * r;
                        float qh[4], kh[4], ko[4], dc[4];
#pragma unroll
                        for (int e = 0; e < 4; ++e) {
                            const float z = fminf(fmaxf(zv[e], -30.0f), 30.0f);
                            const float t = fexp(-z), s = frcp(1.0f + t), sn = t * s;
                            const float f = lb[e] + (1.0f - lb[e]) * s, kk = (1.0f - lb[e]) * sn;
                            float g = flog(f);
                            g += row_shr<1>(g); g += row_shr<2>(g); g += row_shr<4>(g); g += row_shr<8>(g);
                            g = fmaxf(g, -80.0f);
                            const float gl = __shfl(g, 15, 16);
                            const float q = qv[e], qs = q * frcp(1.0f + fexp(-q)) * 0.08838834764831845f;
                            qh[e] = qs * fexp(g); kh[e] = kk * fexp(-g); ko[e] = kk * fexp(gl - g); dc[e] = fexp(gl);
                        }
                        u32x2 w; w.x = cvt_pk_bf16(qh[0], qh[1]); w.y = cvt_pk_bf16(qh[2], qh[3]); *(u32x2*)(QH + (size_t)row * 512 + chp) = w;
                        w.x = cvt_pk_bf16(kh[0], kh[1]); w.y = cvt_pk_bf16(kh[2], kh[3]); *(u32x2*)(KH + (size_t)row * 512 + chp) = w;
                        const unsigned k0 = cvt_pk_bf16(ko[0], ko[1]), k1 = cvt_pk_bf16(ko[2], ko[3]);
                        bf16_t* p = KOT + ((size_t)chunk * 512 + ch) * 16 + fr;
                        p[0] = (bf16_t)k0; p[16] = (bf16_t)(k0 >> 16); p[32] = (bf16_t)k1; p[48] = (bf16_t)(k1 >> 16);
                        if (fr == 15) { u32x2 dw; dw.x = cvt_pk_bf16(dc[0], dc[1]); dw.y = cvt_pk_bf16(dc[2], dc[3]); *(u32x2*)((bf16_t*)DEC + (size_t)chunk * 512 + ch) = dw; }
                        asm volatile("" ::: "memory");
                    }
            }
        }
    }
};
struct EpiRes {
    static constexpr bool PERM = true, AFTER_DRAIN = false;
    const float* xin; float* xout; bf16_t* xb; float* ssout;
    __device__ __forceinline__ void operator()(const f32x4 (&acc)[2][2][4][2], const Unit& u, int wr, int wc, int fr, int fq) const {
        asm volatile("" : "+v"(fr), "+v"(fq));
        const int row0 = u.pm * BM + wr * 64 + fr, col0 = u.pn * BM + wc * 32 + 8 * fq;
#pragma unroll
        for (int ai = 0; ai < 2; ++ai)
#pragma unroll
            for (int m = 0; m < 4; ++m) {
                const int row = row0 + ai * HALF + m * 16; float part = 0.f;
#pragma unroll
                for (int bj = 0; bj < 2; ++bj) {
                    const size_t off = (size_t)row * 1024 + col0 + bj * HALF;
                    f32x4 a = *(const f32x4*)(xin + off), b = *(const f32x4*)(xin + off + 4);
                    a += acc[ai][bj][m][0]; b += acc[ai][bj][m][1];
                    *(f32x4*)(xout + off) = a; *(f32x4*)(xout + off + 4) = b;
                    part += (a[0] * a[0] + a[1] * a[1]) + (a[2] * a[2] + a[3] * a[3]) + (b[0] * b[0] + b[1] * b[1]) + (b[2] * b[2] + b[3] * b[3]);
                    if (xb) { u32x4 w; w.x = cvt_pk_bf16(a[0], a[1]); w.y = cvt_pk_bf16(a[2], a[3]); w.z = cvt_pk_bf16(b[0], b[1]); w.w = cvt_pk_bf16(b[2], b[3]);
                        *(u32x4*)(xb + off) = w; }
                }
                part += __shfl_xor(part, 16); part += __shfl_xor(part, 32);
                if (fq == 0) atomicAdd(ssout + row, part);
            }
    }
};
struct EpiUp {
    static constexpr bool PERM = true, AFTER_DRAIN = false;
    const float* ss; bf16_t* H;
    __device__ __forceinline__ void operator()(const f32x4 (&acc)[2][2][4][2], const Unit& u, int wr, int wc, int fr, int fq) const {
        asm volatile("" : "+v"(fr), "+v"(fq));
        const int row0 = u.pm * BM + wr * 64 + fr, col0 = u.pn * BM + wc * 32 + 8 * fq;
#pragma unroll
        for (int ai = 0; ai < 2; ++ai)
#pragma unroll
            for (int m = 0; m < 4; ++m) {
                const int row = row0 + ai * HALF + m * 16; const float r = __builtin_amdgcn_rsqf(ss[row] * (1.0f / 1024.0f) + 1e-6f);
#pragma unroll
                for (int bj = 0; bj < 2; ++bj) {
                    f32x4 a = acc[ai][bj][m][0] * r, b = acc[ai][bj][m][1] * r;
#pragma unroll
                    for (int e = 0; e < 4; ++e) { a[e] = fmaxf(a[e], 0.f); a[e] *= a[e]; b[e] = fmaxf(b[e], 0.f); b[e] *= b[e]; }
                    u32x4 w; w.x = cvt_pk_bf16(a[0], a[1]); w.y = cvt_pk_bf16(a[2], a[3]); w.z = cvt_pk_bf16(b[0], b[1]); w.w = cvt_pk_bf16(b[2], b[3]);
                    *(u32x4*)(H + (size_t)row * 4096 + col0 + bj * HALF) = w;
                }
            }
    }
};
}

__device__ __forceinline__ float wave_sum(float v) {
#pragma unroll
    for (int o = 1; o < 64; o <<= 1) v += __shfl_xor(v, o);
    return v;
}
__device__ __forceinline__ int win_src_col(int c) {
    if (c < 1024) { const int p = c & 63; return (c & ~63) + (p >> 1) + 32 * (p & 1); }
    if (c >= 1536 && c < 2560) { const int cl = c - 1536, g = cl >> 3, sub = cl & 7; return (sub < 4 ? 1536 : 2048) + 4 * g + (sub & 3); }
    return c;
}
template <bool PERMC>
__device__ __forceinline__ void p0_transpose_item(const float* W, int K, int N, bf16* WT, const float* gain, LAS float* scr, int item, int lane) {
    const int nblk = N / 32, kb = item / nblk, nb = item % nblk, k0 = 64 * kb, n0 = 32 * nb;
    const int pc = n0 + (lane & 31), sc = PERMC ? win_src_col(pc) : pc;
    float wv[32];
#pragma unroll
    for (int i = 0; i < 32; ++i) wv[i] = W[(size_t)(k0 + 2 * i + (lane >> 5)) * N + sc];
#pragma unroll
    for (int i = 0; i < 32; ++i) { const int kk = 2 * i + (lane >> 5); const float g = gain ? gain[k0 + kk] : 1.0f; scr[kk * 33 + (lane & 31)] = wv[i] * g; }
    asm volatile("s_waitcnt lgkmcnt(0)" ::: "memory");
    const int c = lane & 7;
#pragma unroll
    for (int j = 0; j < 4; ++j) { const int n = (lane >> 3) + 8 * j; const LAS float* s = scr + (8 * c) * 33 + n;
        u32x4 o; o.x = pkbf(s[0 * 33], s[1 * 33]); o.y = pkbf(s[2 * 33], s[3 * 33]); o.z = pkbf(s[4 * 33], s[5 * 33]); o.w = pkbf(s[6 * 33], s[7 * 33]);
        *(u32x4*)(WT + (size_t)(n0 + n) * K + k0 + 8 * c) = o; }
    asm volatile("s_waitcnt lgkmcnt(0)" ::: "memory");
}

struct Args {
    const float* in[11]; float* out; unsigned char* ws; float inv_freq[32]; int ph_lo, ph_hi;
};

__device__ __forceinline__ void p0_prologue(const Args& A, LAS unsigned char* lds, int wave, int lane) {
    LAS float* scr = (LAS float*)(lds + wave * 16384);
    const int gw = blockIdx.x * NWAVES + wave, NGW = gridDim.x * NWAVES;
    unsigned char* ws = A.ws;
    const float *norm_mix = A.in[1], *w_in = A.in[2], *w_out = A.in[6], *norm_mlp = A.in[7], *w_up = A.in[8], *w_down = A.in[9];
    constexpr int I_IN = 16 * 112, I_OUT = 16 * 32, I_UP = 16 * 128, I_DN = 64 * 32, I_L = I_IN + I_OUT + I_UP + I_DN;
    for (int it = gw; it < 2 * I_L; it += NGW) {
        const int l = it / I_L; int r = it % I_L;
        if (r < I_IN) { p0_transpose_item<true>(w_in + (size_t)l * D * NIN, D, NIN, (bf16*)(ws + WS_WIN) + (size_t)l * NIN * D, norm_mix + l * D, scr, r, lane); continue; } r -= I_IN;
        if (r < I_OUT) { p0_transpose_item<false>(w_out + (size_t)l * D * D, D, D, (bf16*)(ws + WS_WOUT) + (size_t)l * D * D, nullptr, scr, r, lane); continue; } r -= I_OUT;
        if (r < I_UP) { p0_transpose_item<false>(w_up + (size_t)l * D * FF, D, FF, (bf16*)(ws + WS_WUP) + (size_t)l * FF * D, norm_mlp + l * D, scr, r, lane); continue; } r -= I_UP;
        p0_transpose_item<false>(w_down + (size_t)l * FF * D, FF, D, (bf16*)(ws + WS_WDN) + (size_t)l * D * FF, nullptr, scr, r, lane);
    }
    const float* x = A.in[0]; bf16* xb = (bf16*)(ws + WS_XB); float* ss = (float*)(ws + WS_SS);
    for (int m = gw; m < M; m += 2 * NGW) {
        const int m2 = m + NGW;
        const f32x4* xr = (const f32x4*)(x + (size_t)m * D) + lane; const f32x4* xr2 = (const f32x4*)(x + (size_t)m2 * D) + lane;
        f32x4 v[4], w[4];
#pragma unroll
        for (int j = 0; j < 4; ++j) { v[j] = xr[64 * j]; w[j] = xr2[64 * j]; }
        unsigned long long* o8 = (unsigned long long*)(xb + (size_t)m * D) + lane; unsigned long long* p8 = (unsigned long long*)(xb + (size_t)m2 * D) + lane;
        float s = 0.f, t = 0.f;
#pragma unroll
        for (int j = 0; j < 4; ++j) {
            s += (v[j][0] * v[j][0] + v[j][1] * v[j][1]) + (v[j][2] * v[j][2] + v[j][3] * v[j][3]); t += (w[j][0] * w[j][0] + w[j][1] * w[j][1]) + (w[j][2] * w[j][2] + w[j][3] * w[j][3]);
            o8[64 * j] = (unsigned long long)pkbf(v[j][0], v[j][1]) | ((unsigned long long)pkbf(v[j][2], v[j][3]) << 32);
            p8[64 * j] = (unsigned long long)pkbf(w[j][0], w[j][1]) | ((unsigned long long)pkbf(w[j][2], w[j][3]) << 32); }
        s = wave_sum(s); t = wave_sum(t);
        if (lane == 0) { ss[m] = s; ss[m2] = t; }
    }
    const int gt = blockIdx.x * (NWAVES * 64) + wave * 64 + lane, NGT = gridDim.x * NWAVES * 64;
    for (int i = gt; i < 4 * M; i += NGT) ss[M + i] = 0.f;
    float* rope = (float*)(ws + WS_ROPE);
    for (int i = gt; i < SEQ * 32; i += NGT) {
        const int pos = i >> 5, k = i & 31;
        float ifq = 0.f;
#pragma unroll
        for (int q = 0; q < 32; ++q) if (k == q) ifq = A.inv_freq[q];
        const float ang = (float)pos * ifq;
        const double rev = (double)ang * 0.15915494309189535; const float fr = (float)(rev - __builtin_rint(rev));
        rope[2 * i] = __builtin_amdgcn_cosf(fr); rope[2 * i + 1] = __builtin_amdgcn_sinf(fr);
    }
}

constexpr int VRS = 144;
__device__ __forceinline__ int crow(int i, int h) { return (i & 3) + 8 * (i >> 2) + 4 * h; }
__device__ __forceinline__ void attn_qk_pv(const bf16x8 (&kf)[4], const bf16x8 (&qf)[4], const bf16x8 va00, const bf16x8 va01, const bf16x8 va10, const bf16x8 va11,
                                           f32x16& o0, f32x16& o1, float& mrun, float& lrun, int mode, int r32, int h2) {
    f32x16 sc;
#pragma unroll
    for (int i = 0; i < 16; ++i) sc[i] = 0.f;
    __builtin_amdgcn_s_setprio(1);
#pragma unroll
    for (int s = 0; s < 4; ++s) sc = __builtin_amdgcn_mfma_f32_32x32x16_bf16(kf[s], qf[s], sc, 0, 0, 0);
    __builtin_amdgcn_s_setprio(0);
    if (mode == 1) {
#pragma unroll
        for (int i = 0; i < 16; ++i) if (crow(i, h2) < r32) sc[i] = -1e30f;
    }
    if (mode == 2) {
#pragma unroll
        for (int i = 0; i < 16; ++i) if (crow(i, h2) > r32) sc[i] = -1e30f;
    }
    float mx = sc[0];
#pragma unroll
    for (int i = 1; i < 16; ++i) mx = fmaxf(mx, sc[i]);
    mx = fmaxf(mx, __shfl_xor(mx, 32));
    const float mn = fmaxf(mrun, mx), alpha = fexp(mrun - mn); mrun = mn;
    float ps = 0.f;
#pragma unroll
    for (int i = 0; i < 16; ++i) { sc[i] = fexp(sc[i] - mn); ps += sc[i]; }
    lrun = lrun * alpha + ps;
#pragma unroll
    for (int i = 0; i < 16; ++i) { o0[i] *= alpha; o1[i] *= alpha; }
    u32x4 pw0, pw1;
    pw0.x = pkbf(sc[0], sc[1]); pw0.y = pkbf(sc[2], sc[3]); pw0.z = pkbf(sc[4], sc[5]); pw0.w = pkbf(sc[6], sc[7]);
    pw1.x = pkbf(sc[8], sc[9]); pw1.y = pkbf(sc[10], sc[11]); pw1.z = pkbf(sc[12], sc[13]); pw1.w = pkbf(sc[14], sc[15]);
    const bf16x8 pb0 = __builtin_bit_cast(bf16x8, pw0), pb1 = __builtin_bit_cast(bf16x8, pw1);
    __builtin_amdgcn_s_setprio(1);
    o0 = __builtin_amdgcn_mfma_f32_32x32x16_bf16(va00, pb0, o0, 0, 0, 0); o0 = __builtin_amdgcn_mfma_f32_32x32x16_bf16(va01, pb1, o0, 0, 0, 0);
    o1 = __builtin_amdgcn_mfma_f32_32x32x16_bf16(va10, pb0, o1, 0, 0, 0); o1 = __builtin_amdgcn_mfma_f32_32x32x16_bf16(va11, pb1, o1, 0, 0, 0);
    __builtin_amdgcn_s_setprio(0);
}
__device__ __forceinline__ void attn_store(const f32x16& o0, const f32x16& o1, float mrun, float lrun, bf16* OP, float* LSE, int p, size_t tokq, int h, int h2) {
    const float lt = lrun + __shfl_xor(lrun, 32), inv = 1.0f / lt;
    bf16* op = OP + ((size_t)p * M + tokq) * 512 + h * 64 + 4 * h2;
#pragma unroll
    for (int g = 0; g < 4; ++g) {
        u32x2 w; w.x = pkbf(o0[4 * g] * inv, o0[4 * g + 1] * inv); w.y = pkbf(o0[4 * g + 2] * inv, o0[4 * g + 3] * inv); *(u32x2*)(op + 8 * g) = w;
        w.x = pkbf(o1[4 * g] * inv, o1[4 * g + 1] * inv); w.y = pkbf(o1[4 * g + 2] * inv, o1[4 * g + 3] * inv); *(u32x2*)(op + 32 + 8 * g) = w;
    }
    if (h2 == 0) LSE[((size_t)p * M + tokq) * 8 + h] = mrun + flog(lt);
}
constexpr int ATT_ITEMS = NB * 8 * 3 * 64;
__device__ __forceinline__ void attn_item(int item, const bf16* Q, const bf16* K, const bf16* V, bf16* OP, float* LSE, LAS unsigned char* vl, int lane) {
    const int x = item & 63; const int t3 = item >> 6; const int p = t3 % 3, bh = t3 / 3, b = bh >> 3, h = bh & 7;
    const int dsh = 2 * p, per2 = 64 >> dsh, res = x >> (6 - dsh), qp2 = x & (per2 - 1), q0 = qp2 * 64;
    const int r32 = lane & 31, h2 = lane >> 5;
    const size_t tokA = (size_t)b * SEQ + ((size_t)(q0 + r32) << dsh) + res, tokB = (size_t)b * SEQ + ((size_t)(q0 + 32 + r32) << dsh) + res;
    bf16x8 qfA[4], qfB[4];
    { const bf16* qa = Q + tokA * 512 + h * 64 + 8 * h2; const bf16* qb = Q + tokB * 512 + h * 64 + 8 * h2;
#pragma unroll
      for (int s = 0; s < 4; ++s) { qfA[s] = *(const bf16x8*)(qa + 16 * s); qfB[s] = *(const bf16x8*)(qb + 16 * s); } }
    f32x16 oA0, oA1, oB0, oB1;
#pragma unroll
    for (int i = 0; i < 16; ++i) { oA0[i] = 0.f; oA1[i] = 0.f; oB0[i] = 0.f; oB1[i] = 0.f; }
    float mA = -1e30f, lA = 0.f, mB = -1e30f, lB = 0.f;
    const int j_lo = q0 >= 128 ? 0 : (128 - q0) >> 5;
    const unsigned vbase = (unsigned)(size_t)vl;
    const int i16 = lane & 15, tq = i16 >> 2, tp = i16 & 3, blk = (lane >> 4) & 1;
    const unsigned traddr = vbase + (4 * h2 + tq) * VRS + 32 * blk + 8 * tp;
    bf16x8 kf[4]; u32x4 vv[4];
#define ATT_LOAD(KF, VV, tile) do { const int kt0_ = q0 - 128 + 32 * (tile); \
        const bf16* kp_ = K + ((size_t)b * SEQ + ((size_t)(kt0_ + r32) << dsh) + res) * 512 + h * 64 + 8 * h2; \
        _Pragma("unroll") for (int s_ = 0; s_ < 4; ++s_) KF[s_] = *(const bf16x8*)(kp_ + 16 * s_); \
        _Pragma("unroll") for (int i_ = 0; i_ < 4; ++i_) { const int id_ = lane + 64 * i_, vr_ = id_ >> 3, vc_ = id_ & 7; \
            VV[i_] = *(const u32x4*)(V + ((size_t)b * SEQ + ((size_t)(kt0_ + vr_) << dsh) + res) * 512 + h * 64 + 8 * vc_); } } while (0)
    ATT_LOAD(kf, vv, j_lo);
    for (int j = j_lo; j < 6; ++j) {
        bf16x8 kn[4]; u32x4 vn[4];
        { const int jn = j < 5 ? j + 1 : 5; ATT_LOAD(kn, vn, jn); }
#pragma unroll
        for (int i = 0; i < 4; ++i) { const int id = lane + 64 * i, vr = id >> 3, vc = id & 7; *(LAS u32x4*)(vl + vr * VRS + vc * 16) = vv[i]; }
        s16x4 t0, t1, t2, t3r, t4, t5, t6, t7;
        asm volatile("s_waitcnt lgkmcnt(0)\n\t"
                     "ds_read_b64_tr_b16 %0, %8\n\tds_read_b64_tr_b16 %1, %8 offset:1152\n\tds_read_b64_tr_b16 %2, %8 offset:2304\n\tds_read_b64_tr_b16 %3, %8 offset:3456\n\t"
                     "ds_read_b64_tr_b16 %4, %8 offset:64\n\tds_read_b64_tr_b16 %5, %8 offset:1216\n\tds_read_b64_tr_b16 %6, %8 offset:2368\n\tds_read_b64_tr_b16 %7, %8 offset:3520\n\t"
                     "s_waitcnt lgkmcnt(0)"
                     : "=&v"(t0), "=&v"(t1), "=&v"(t2), "=&v"(t3r), "=&v"(t4), "=&v"(t5), "=&v"(t6), "=&v"(t7) : "v"(traddr) : "memory");
        const bf16x8 va00 = __builtin_shufflevector(t0, t1, 0, 1, 2, 3, 4, 5, 6, 7), va01 = __builtin_shufflevector(t2, t3r, 0, 1, 2, 3, 4, 5, 6, 7);
        const bf16x8 va10 = __builtin_shufflevector(t4, t5, 0, 1, 2, 3, 4, 5, 6, 7), va11 = __builtin_shufflevector(t6, t7, 0, 1, 2, 3, 4, 5, 6, 7);
        if (j <= 4) attn_qk_pv(kf, qfA, va00, va01, va10, va11, oA0, oA1, mA, lA, j == 0 ? 1 : (j == 4 ? 2 : 0), r32, h2);
        if (j >= 1) attn_qk_pv(kf, qfB, va00, va01, va10, va11, oB0, oB1, mB, lB, j == 1 ? 1 : (j == 5 ? 2 : 0), r32, h2);
#pragma unroll
        for (int i = 0; i < 4; ++i) { kf[i] = kn[i]; vv[i] = vn[i]; }
    }
#undef ATT_LOAD
    attn_store(oA0, oA1, mA, lA, OP, LSE, p, tokA, h, h2);
    attn_store(oB0, oB1, mB, lB, OP, LSE, p, tokB, h, h2);
}

constexpr int HGC_SLOT = 16896, HGC_D = 6, HGC_AM = HGC_D * HGC_SLOT;
constexpr int HG_WGS = 64;
__device__ __forceinline__ void hgrn_coop(int bh, int half, int wave, const bf16* QH, const bf16* KH, const bf16* KOT, const bf16* VT, const float* DEC, bf16* REC, LAS unsigned char* ring, int lane) {
    const int i16 = lane & 15, fq = lane >> 4, b = bh >> 2, h = bh & 3;
    const int gc0 = b * (SEQ / 16);
    if (wave >= 4) {
        const int pw = wave - 4;
        unsigned off[4]; const bf16* src; int dst; int nops;
        if (pw < 2) {
#pragma unroll
            for (int j = 0; j < 4; ++j) { const int P = 64 * j + lane, tok = P >> 4, pcg = (P & 15) ^ (tok & 15); off[j] = (unsigned)(tok * 512 + 128 * h + 8 * pcg); }
            src = pw == 0 ? QH : KH; dst = pw * 4096; nops = 4;
        } else if (pw == 2) {
#pragma unroll
            for (int j = 0; j < 4; ++j) off[j] = (unsigned)(128 * h * 16 + (64 * j + lane) * 8);
            src = KOT; dst = 8192; nops = 4;
        } else {
#pragma unroll
            for (int j = 0; j < 4; ++j) off[j] = (unsigned)((128 * h + 64 * half) * 16 + (64 * (j & 1) + lane) * 8);
            src = VT; dst = 12288; nops = 2;
        }
        const bf16* DECb = (const bf16*)DEC; const unsigned odec = (unsigned)(128 * h + lane * 2);
#define HGC_DMA(gc, slot) do { LAS unsigned char* sb_ = ring + (slot) * HGC_SLOT; const size_t r_ = (size_t)(gc) * (16 * 512); \
            __builtin_amdgcn_global_load_lds((const unsigned*)(src + r_ + off[0]), (LAS unsigned*)(sb_ + dst), 16, 0, 0); \
            __builtin_amdgcn_global_load_lds((const unsigned*)(src + r_ + off[1]), (LAS unsigned*)(sb_ + dst + 1024), 16, 0, 0); \
            if (nops == 4) { __builtin_amdgcn_global_load_lds((const unsigned*)(src + r_ + off[2]), (LAS unsigned*)(sb_ + dst + 2048), 16, 0, 0); \
                             __builtin_amdgcn_global_load_lds((const unsigned*)(src + r_ + off[3]), (LAS unsigned*)(sb_ + dst + 3072), 16, 0, 0); } \
            else { __builtin_amdgcn_global_load_lds((const unsigned*)(DECb + (size_t)(gc) * 512 + odec), (LAS unsigned*)(sb_ + 16384), 4, 0, 0); \
                   __builtin_amdgcn_global_load_lds((const unsigned*)(DECb + (size_t)(gc) * 512 + odec), (LAS unsigned*)(sb_ + 16384), 4, 0, 0); } } while (0)
        HGC_DMA(gc0 + 0, 0); HGC_DMA(gc0 + 1, 1); HGC_DMA(gc0 + 2, 2); HGC_DMA(gc0 + 3, 3); HGC_DMA(gc0 + 4, 4);
        asm volatile("s_waitcnt vmcnt(16)" ::: "memory");
        __builtin_amdgcn_s_barrier();
        int sl = 0;
        for (int c = 0; c < SEQ / 16; ++c) {
            asm volatile("s_waitcnt vmcnt(12)" ::: "memory");
            __builtin_amdgcn_s_barrier();
            asm volatile("" ::: "memory");
            { const int cn = c + 5 < SEQ / 16 ? c + 5 : SEQ / 16 - 1; HGC_DMA(gc0 + cn, sl == 0 ? 5 : sl - 1); }
            sl = sl == 5 ? 0 : sl + 1;
        }
        asm volatile("s_waitcnt vmcnt(0)" ::: "memory");
#undef HGC_DMA
        return;
    }
    const int vs = 4 * half + wave;
    f32x4 S[8];
#pragma unroll
    for (int k = 0; k < 8; ++k) S[k] = (f32x4){0.f, 0.f, 0.f, 0.f};
    unsigned fqk[4];
#pragma unroll
    for (int a = 0; a < 4; ++a) fqk[a] = (unsigned)((i16 * 16 + ((4 * a + fq) ^ i16)) * 16);
    const unsigned fko = (unsigned)(8192 + i16 * 32 + fq * 8), fvt = (unsigned)(12288 + (16 * wave + i16) * 32 + fq * 8), fdc = (unsigned)(16384 + fq * 8);
    const unsigned fam = (unsigned)(HGC_AM + lane * 8);
    const f32x4 z4 = (f32x4){0.f, 0.f, 0.f, 0.f};
#define HGC_SCORES(sl_, buf) do { const LAS unsigned char* sq_ = ring + (sl_) * HGC_SLOT; \
        bf16x8 qa_[4], ka_[4]; \
        _Pragma("unroll") for (int a = 0; a < 4; ++a) { qa_[a] = *(const LAS bf16x8*)(sq_ + fqk[a]); ka_[a] = *(const LAS bf16x8*)(sq_ + 4096 + fqk[a]); } \
        f32x4 p0 = __builtin_amdgcn_mfma_f32_16x16x32_bf16(ka_[0], qa_[0], z4, 0, 0, 0), p1 = __builtin_amdgcn_mfma_f32_16x16x32_bf16(ka_[1], qa_[1], z4, 0, 0, 0); \
        f32x4 p2 = __builtin_amdgcn_mfma_f32_16x16x32_bf16(ka_[2], qa_[2], z4, 0, 0, 0), p3 = __builtin_amdgcn_mfma_f32_16x16x32_bf16(ka_[3], qa_[3], z4, 0, 0, 0); \
        asm volatile("s_nop 7" : "+v"(p0), "+v"(p1), "+v"(p2), "+v"(p3)); \
        f32x4 at = (p0 + p1) + (p2 + p3); \
        _Pragma("unroll") for (int r = 0; r < 4; ++r) if (4 * fq + r > i16) at[r] = 0.f; \
        u32x2 aw; aw.x = pkbf(at[0], at[1]); aw.y = pkbf(at[2], at[3]); \
        *(LAS u32x2*)(ring + fam + (buf) * 512) = aw; } while (0)
    __builtin_amdgcn_s_barrier();
    if (wave == 0) HGC_SCORES(0, 0);
    int sl = 0;
    for (int c = 0; c < SEQ / 16; ++c) {
        asm volatile("s_waitcnt lgkmcnt(0)" ::: "memory");
        __builtin_amdgcn_s_barrier();
        asm volatile("" ::: "memory");
        const int sl1 = sl == 5 ? 0 : sl + 1;
        if (wave == ((c + 1) & 3) && c + 1 < SEQ / 16) HGC_SCORES(sl1, (c + 1) & 1);
        const LAS unsigned char* sb = ring + sl * HGC_SLOT;
        bf16x8 qa[4]; s16x4 ko[8]; u32x2 dc[8];
#pragma unroll
        for (int a = 0; a < 4; ++a) qa[a] = *(const LAS bf16x8*)(sb + fqk[a]);
        const s16x4 vb = *(const LAS s16x4*)(sb + fvt);
        const s16x4 am = *(const LAS s16x4*)(ring + fam + (c & 1) * 512);
#pragma unroll
        for (int k = 0; k < 8; ++k) { ko[k] = *(const LAS s16x4*)(sb + fko + k * 512); dc[k] = *(const LAS u32x2*)(sb + fdc + k * 32); }
        f32x4 oi[4];
#pragma unroll
        for (int a = 0; a < 4; ++a) {
            u32x4 sw; sw.x = pkbf(S[2 * a][0], S[2 * a][1]); sw.y = pkbf(S[2 * a][2], S[2 * a][3]); sw.z = pkbf(S[2 * a + 1][0], S[2 * a + 1][1]); sw.w = pkbf(S[2 * a + 1][2], S[2 * a + 1][3]);
            oi[a] = __builtin_amdgcn_mfma_f32_16x16x32_bf16(qa[a], __builtin_bit_cast(bf16x8, sw), z4, 0, 0, 0);
        }
        f32x4 o = __builtin_amdgcn_mfma_f32_16x16x16bf16_1k(am, vb, z4, 0, 0, 0);
#pragma unroll
        for (int k = 0; k < 8; ++k) { const f32x4 d = (f32x4){bflo(dc[k].x), bfhi(dc[k].x), bflo(dc[k].y), bfhi(dc[k].y)}; S[k] = __builtin_amdgcn_mfma_f32_16x16x16bf16_1k(ko[k], vb, d * S[k], 0, 0, 0); }
        asm volatile("s_nop 7" : "+v"(o), "+v"(oi[0]), "+v"(oi[1]), "+v"(oi[2]), "+v"(oi[3]));
        o = (o + oi[0]) + (oi[1] + oi[2]) + oi[3];
        bf16* rp = REC + ((size_t)(gc0 + c) * 16 + 4 * fq) * 512 + 128 * h + 16 * vs + i16;
        const unsigned w0 = pkbf(o[0], o[1]), w1 = pkbf(o[2], o[3]);
        rp[0] = (bf16)w0; rp[512] = (bf16)(w0 >> 16); rp[1024] = (bf16)w1; rp[1536] = (bf16)(w1 >> 16);
        sl = sl1;
    }
#undef HGC_SCORES
}

__device__ __forceinline__ void combine_row(int row, const bf16* __restrict__ OP, const float* __restrict__ LSE, const bf16* __restrict__ REC, const bf16* __restrict__ GATE, const float* __restrict__ again, const float* __restrict__ hgain, bf16* __restrict__ MIX, int lane) {
    const int hh = lane >> 3;
    float l0 = LSE[((size_t)0 * M + row) * 8 + hh], l1 = LSE[((size_t)1 * M + row) * 8 + hh], l2 = LSE[((size_t)2 * M + row) * 8 + hh];
    const float mx = fmaxf(l0, fmaxf(l1, l2)); l0 = fexp(l0 - mx); l1 = fexp(l1 - mx); l2 = fexp(l2 - mx);
    const float inv = 1.0f / (l0 + l1 + l2); l0 *= inv; l1 *= inv; l2 *= inv;
    const u32x4 a0 = *(const u32x4*)(OP + ((size_t)0 * M + row) * 512 + 8 * lane), a1 = *(const u32x4*)(OP + ((size_t)1 * M + row) * 512 + 8 * lane), a2 = *(const u32x4*)(OP + ((size_t)2 * M + row) * 512 + 8 * lane);
    float v[8]; float s = 0.f;
#pragma unroll
    for (int e = 0; e < 4; ++e) {
        v[2 * e] = l0 * bflo(a0[e]) + l1 * bflo(a1[e]) + l2 * bflo(a2[e]); v[2 * e + 1] = l0 * bfhi(a0[e]) + l1 * bfhi(a1[e]) + l2 * bfhi(a2[e]);
        s += v[2 * e] * v[2 * e] + v[2 * e + 1] * v[2 * e + 1];
    }
    s = wave_sum(s);
    const float ra = __builtin_amdgcn_rsqf(s * (1.0f / 512.0f) + NEPS);
    const f32x4 g0 = *(const f32x4*)(again + 8 * lane), g1 = *(const f32x4*)(again + 8 * lane + 4);
    u32x4 w; w.x = pkbf(v[0] * ra * g0[0], v[1] * ra * g0[1]); w.y = pkbf(v[2] * ra * g0[2], v[3] * ra * g0[3]); w.z = pkbf(v[4] * ra * g1[0], v[5] * ra * g1[1]); w.w = pkbf(v[6] * ra * g1[2], v[7] * ra * g1[3]);
    *(u32x4*)(MIX + (size_t)row * 1024 + 8 * lane) = w;
    const u32x4 r4 = *(const u32x4*)(REC + (size_t)row * 512 + 8 * lane), g4 = *(const u32x4*)(GATE + (size_t)row * 512 + 8 * lane);
    float o[8]; float s2 = 0.f;
#pragma unroll
    for (int e = 0; e < 4; ++e) { o[2 * e] = bflo(r4[e]); o[2 * e + 1] = bfhi(r4[e]); s2 += o[2 * e] * o[2 * e] + o[2 * e + 1] * o[2 * e + 1]; }
    s2 += __shfl_xor(s2, 1); s2 += __shfl_xor(s2, 2); s2 += __shfl_xor(s2, 4); s2 += __shfl_xor(s2, 8);
    const float rh = __builtin_amdgcn_rsqf(s2 * (1.0f / 128.0f) + NEPS);
    const int hc = (8 * lane) & 127;
    const f32x4 h0 = *(const f32x4*)(hgain + hc), h1 = *(const f32x4*)(hgain + hc + 4);
    w.x = pkbf(o[0] * rh * h0[0] * bflo(g4[0]), o[1] * rh * h0[1] * bfhi(g4[0])); w.y = pkbf(o[2] * rh * h0[2] * bflo(g4[1]), o[3] * rh * h0[3] * bfhi(g4[1]));
    w.z = pkbf(o[4] * rh * h1[0] * bflo(g4[2]), o[5] * rh * h1[1] * bfhi(g4[2])); w.w = pkbf(o[6] * rh * h1[2] * bflo(g4[3]), o[7] * rh * h1[3] * bfhi(g4[3]));
    *(u32x4*)(MIX + (size_t)row * 1024 + 512 + 8 * lane) = w;
}

#define XB_TMO      128
#define XB_XCNT(j)  (256  + 64 * (j))
#define XB_XSUB(j)  (1280 + 64 * (j))
#define XB_XGEN(j)  (2304 + 64 * (j))
#define XB_TOP      3328
#define XB_TOPGEN   3392
#define XCD_BAR_WORDS 3456
#define XB_SPIN_CAP (1u << 18)

__device__ __forceinline__ unsigned xb_ld(unsigned* p)              { return __hip_atomic_load(p, __ATOMIC_RELAXED, __HIP_MEMORY_SCOPE_AGENT); }
__device__ __forceinline__ unsigned xb_add(unsigned* p, unsigned v) { return __hip_atomic_fetch_add(p, v, __ATOMIC_RELAXED, __HIP_MEMORY_SCOPE_AGENT); }
__device__ __forceinline__ unsigned xb_xcc_id() { return (unsigned)__builtin_amdgcn_s_getreg((3 << 11) | 20) & 0xFu; }
#define XB_SPIN(cond, bar) do { unsigned _sp = 0; while (cond) { __builtin_amdgcn_s_sleep(0); \
    if ((++_sp & 255u) == 0u) { if (xb_ld(&(bar)[XB_TMO])) break; if (_sp > XB_SPIN_CAP) { atomicAdd(&(bar)[XB_TMO], 1u); break; } } } } while (0)

struct XcdBarrier {
    unsigned* bar; unsigned x;
    volatile LAS unsigned* st;
};

__device__ __forceinline__ XcdBarrier xcd_barrier_post(unsigned* bar, volatile LAS unsigned* st) {
    XcdBarrier b; b.bar = bar; b.x = xb_xcc_id(); b.st = st;
    if (threadIdx.x == 0) (void)xb_add(&bar[XB_XCNT(b.x)], 1u);
    return b;
}
__device__ __forceinline__ void xcd_barrier_complete(unsigned* bar, unsigned x, unsigned& nloc, unsigned& nx) {
    const unsigned G = gridDim.x * gridDim.y * gridDim.z;
    unsigned sum, cnt, mine, sp = 0u;
    for (;;) {
        sum = 0u; cnt = 0u; mine = 0u;
#pragma unroll
        for (unsigned j = 0; j < 16; ++j) { const unsigned c = xb_ld(&bar[XB_XCNT(j)]); sum += c; cnt += (c > 0u) ? 1u : 0u; mine = (j == x) ? c : mine; }
        if (sum == G) break;
        __builtin_amdgcn_s_sleep(1);
        if ((++sp & 255u) == 0u) { if (xb_ld(&bar[XB_TMO])) break; if (sp > XB_SPIN_CAP) { atomicAdd(&bar[XB_TMO], 1u); break; } }
    }
    nloc = mine > 0u ? mine : 1u; nx = cnt > 0u ? cnt : 1u;
}

__device__ __forceinline__ void xcd_barrier(const XcdBarrier& b) {
    asm volatile("s_waitcnt vmcnt(0)" ::: "memory");
    __syncthreads();
    if (threadIdx.x == 0) {
        unsigned* bar = b.bar;
        __builtin_amdgcn_s_waitcnt(0);
        unsigned nloc = b.st[0], nx = b.st[1];
        if (nloc == 0u) { xcd_barrier_complete(bar, b.x, nloc, nx); b.st[0] = nloc; b.st[1] = nx; }
        const unsigned old = xb_add(&bar[XB_XSUB(b.x)], 1u);
        const unsigned gen = old / nloc;
        if (old + 1u == (gen + 1u) * nloc) {
            __builtin_amdgcn_fence(__ATOMIC_RELEASE, "agent");
            asm volatile("s_waitcnt vmcnt(0)" ::: "memory");
            const unsigned og = xb_add(&bar[XB_TOP], 1u);
            const unsigned tg = og / nx;
            if (og + 1u == (tg + 1u) * nx) xb_add(&bar[XB_TOPGEN], 1u);
            else XB_SPIN(xb_ld(&bar[XB_TOPGEN]) == tg, bar);
            __builtin_amdgcn_fence(__ATOMIC_ACQUIRE, "agent");
            xb_add(&bar[XB_XGEN(b.x)], 1u);
            asm volatile("s_waitcnt vmcnt(0)" ::: "memory");
        } else {
            XB_SPIN(xb_ld(&bar[XB_XGEN(b.x)]) == gen, bar);
            __builtin_amdgcn_fence(__ATOMIC_ACQUIRE, "agent");
            asm volatile("s_waitcnt vmcnt(0)" ::: "memory");
        }
    }
    __syncthreads();
}

#ifndef EPI_SKIP
#define EPI_SKIP 0
#endif
#ifndef DBG_MASK
#define DBG_MASK 63
#endif
constexpr int N_PHASES = 14;

template <int PH>
__device__ __forceinline__ void run_phase(const Args& A, LAS unsigned char* lds, const int wave) {
    const int G = gridDim.x;
    const int lane = (int)__builtin_amdgcn_mbcnt_hi(~0u, __builtin_amdgcn_mbcnt_lo(~0u, 0u));
    unsigned char* ws = A.ws;
    if constexpr (PH == 0) {
        p0_prologue(A, lds, wave, lane);
    } else if constexpr (PH == N_PHASES - 1) {
        float* X = A.out; const float* ssf = (const float*)(ws + WS_SS) + 4 * (size_t)M; const float* gn = A.in[10];
        const f32x4 g0 = *((const f32x4*)gn + lane), g1 = *((const f32x4*)gn + lane + 64), g2 = *((const f32x4*)gn + lane + 128), g3 = *((const f32x4*)gn + lane + 192);
        for (int m = blockIdx.x * NWAVES + wave; m < M; m += 2 * G * NWAVES) {
            const int m2 = m + G * NWAVES;
            const float r = __builtin_amdgcn_rsqf(ssf[m] * (1.0f / 1024.0f) + NEPS), r2 = __builtin_amdgcn_rsqf(ssf[m2] * (1.0f / 1024.0f) + NEPS);
            f32x4* xr = (f32x4*)(X + (size_t)m * D) + lane; f32x4* xr2 = (f32x4*)(X + (size_t)m2 * D) + lane;
            f32x4 v[4], w[4];
#pragma unroll
            for (int j = 0; j < 4; ++j) { v[j] = xr[64 * j]; w[j] = xr2[64 * j]; }
            xr[0] = v[0] * r * g0; xr[64] = v[1] * r * g1; xr[128] = v[2] * r * g2; xr[192] = v[3] * r * g3;
            xr2[0] = w[0] * r2 * g0; xr2[64] = w[1] * r2 * g1; xr2[128] = w[2] * r2 * g2; xr2[192] = w[3] * r2 * g3;
        }
    } else {
        constexpr int l = (PH - 1) / 6, sp = (PH - 1) % 6;
        float* SS = (float*)(ws + WS_SS);
        if constexpr (sp == 0) {
            const float* ss_in = l == 0 ? SS : SS + 2 * (size_t)M;
            pg8::Gemm g{(const bf16*)(ws + WS_XB), (const bf16*)(ws + WS_WIN) + (size_t)l * NIN * D, M, NIN, D}; pg8::StaticOrder S; S.init(M, NIN, G, (int)blockIdx.x, 4);
            pg8::EpiIn E{ss_in, (const float*)(ws + WS_ROPE), A.in[4], l, ws + WS_A, (float*)(ws + WS_DEC)};
            pg8::gemm_phase<pg8::EpiIn, pg8::StaticOrder, true, true>(lds, g, S, E, wave);
        } else if constexpr (sp == 1) {
            bf16 *Qb = (bf16*)(ws + WS_A), *Kb = (bf16*)(ws + WS_A + 32 * MiB), *Vb = (bf16*)(ws + WS_A + 64 * MiB), *QH = (bf16*)(ws + WS_A + 96 * MiB), *KH = (bf16*)(ws + WS_A + 128 * MiB),
                 *KOT = (bf16*)(ws + WS_A + 160 * MiB), *VT = (bf16*)(ws + WS_A + 192 * MiB);
            if (G > 2 * HG_WGS) {
                if ((int)blockIdx.x < HG_WGS) {
                    hgrn_coop((int)blockIdx.x >> 1, (int)blockIdx.x & 1, wave, QH, KH, KOT, VT, (const float*)(ws + WS_DEC), (bf16*)(ws + WS_REC), lds, lane);
                } else {
                    LAS unsigned char* vl = lds + wave * (32 * VRS);
                    for (int it = ((int)blockIdx.x - HG_WGS) * 8 + wave; it < ATT_ITEMS; it += (G - HG_WGS) * 8) attn_item(it, Qb, Kb, Vb, (bf16*)(ws + WS_OP), (float*)(ws + WS_LSE), vl, lane);
                }
            }
        } else if constexpr (sp == 2) {
            const float* again = A.in[3] + l * 512; const float* hgain = A.in[5] + l * 128;
            for (int m = blockIdx.x * NWAVES + wave; m < M; m += 2 * G * NWAVES) {
                combine_row(m, (const bf16*)(ws + WS_OP), (const float*)(ws + WS_LSE), (const bf16*)(ws + WS_REC), (const bf16*)(ws + WS_A + 224 * MiB), again, hgain, (bf16*)(ws + WS_A), lane);
                combine_row(m + G * NWAVES, (const bf16*)(ws + WS_OP), (const float*)(ws + WS_LSE), (const bf16*)(ws + WS_REC), (const bf16*)(ws + WS_A + 224 * MiB), again, hgain, (bf16*)(ws + WS_A), lane);
            }
        } else if constexpr (sp == 3) {
            pg8::Gemm g{(const bf16*)(ws + WS_A), (const bf16*)(ws + WS_WOUT) + (size_t)l * D * D, M, D, D}; pg8::StaticOrder S; S.init(M, D, G, (int)blockIdx.x, 4);
            pg8::EpiRes E{l == 0 ? A.in[0] : A.out, A.out, (bf16*)(ws + WS_XB), SS + (size_t)(1 + 2 * l) * M};
            pg8::gemm_phase<pg8::EpiRes, pg8::StaticOrder, true, true>(lds, g, S, E, wave);
        } else if constexpr (sp == 4) {
            pg8::Gemm g{(const bf16*)(ws + WS_XB), (const bf16*)(ws + WS_WUP) + (size_t)l * FF * D, M, FF, D}; pg8::StaticOrder S; S.init(M, FF, G, (int)blockIdx.x);
            pg8::EpiUp E{SS + (size_t)(1 + 2 * l) * M, (bf16*)(ws + WS_A)};
            pg8::gemm_phase<pg8::EpiUp, pg8::StaticOrder, true, true>(lds, g, S, E, wave);
        } else {
            pg8::Gemm g{(const bf16*)(ws + WS_A), (const bf16*)(ws + WS_WDN) + (size_t)l * D * FF, M, D, FF}; pg8::StaticOrder S; S.init(M, D, G, (int)blockIdx.x);
            pg8::EpiRes E{A.out, A.out, l + 1 < NLAYER ? (bf16*)(ws + WS_XB) : nullptr, SS + (size_t)(2 + 2 * l) * M};
            pg8::gemm_phase<pg8::EpiRes, pg8::StaticOrder, true, true>(lds, g, S, E, wave);
        }
    }
}

__global__ void __launch_bounds__(NWAVES * 64, 2) hymba_fwd(Args A) {
    extern __shared__ __attribute__((aligned(16))) unsigned char lds_raw[];
    LAS unsigned char* lds = (LAS unsigned char*)lds_raw;
    const int wave = __builtin_amdgcn_readfirstlane((int)threadIdx.x >> 6);
    cg::grid_group grid = cg::this_grid();
    const int lo = A.ph_lo, hi = A.ph_hi;
    volatile LAS unsigned* bst = (volatile LAS unsigned*)(lds + LDS_BYTES - 64);
    if (threadIdx.x == 0) { bst[0] = 0u; bst[1] = 0u; }
    __syncthreads();
    const XcdBarrier xbar = xcd_barrier_post((unsigned*)(A.ws + WS_BAR), bst);
    if (hi == 0x7fffffff) grid.sync();
#define PHASE(k) if (lo <= (k) && (k) < hi) { run_phase<k>(A, lds, wave); if ((k) + 1 < hi) xcd_barrier(xbar); }
    PHASE(0) PHASE(1) PHASE(2) PHASE(3) PHASE(4) PHASE(5) PHASE(6) PHASE(7) PHASE(8) PHASE(9) PHASE(10) PHASE(11) PHASE(12) PHASE(13)
#undef PHASE
}

extern "C" void kernel_launch(void* const* d_in, const int* in_sizes, int n_in, void* d_out, int out_size, void* d_ws, size_t ws_size, hipStream_t stream) {
    static int grid = 0;
    if (grid == 0) {
        if (n_in != 11 || in_sizes[0] != M * D || out_size != M * D || ws_size < WS_END) { fprintf(stderr, "kernel_launch: unexpected shapes (n_in %d, in0 %d, out %d, ws %zu)\n", n_in, n_in > 0 ? in_sizes[0] : -1, out_size, ws_size); grid = -1; return; }
        int dev = 0, cus = 0, per_cu = 0;
        if (hipGetDevice(&dev) != hipSuccess || hipDeviceGetAttribute(&cus, hipDeviceAttributeMultiprocessorCount, dev) != hipSuccess) { grid = -1; return; }
        if (hipFuncSetAttribute((const void*)hymba_fwd, hipFuncAttributeMaxDynamicSharedMemorySize, LDS_BYTES) != hipSuccess) { fprintf(stderr, "kernel_launch: hipFuncSetAttribute failed\n"); grid = -1; return; }
        if (hipOccupancyMaxActiveBlocksPerMultiprocessor(&per_cu, (const void*)hymba_fwd, NWAVES * 64, LDS_BYTES) != hipSuccess || per_cu < 1) { fprintf(stderr, "kernel_launch: occupancy query says %d\n", per_cu); per_cu = 1; }
        (void)hipGetLastError();
        grid = cus * 1;
    }
    if (grid < 0) return;
    Args a{};
    for (int i = 0; i < 11; ++i) a.in[i] = (const float*)d_in[i];
    a.out = (float*)d_out; a.ws = (unsigned char*)d_ws;
    for (int i = 0; i < 32; ++i) a.inv_freq[i] = (float)pow(10000.0, -(double)i / 32.0);
#if N_LAUNCH_MODE == 1
    if (hipMemsetAsync((char*)d_ws + WS_BAR, 0, 16384, stream) != hipSuccess) { fprintf(stderr, "kernel_launch: memset of the barrier words failed\n"); return; }
    a.ph_lo = 0; a.ph_hi = N_PHASES;
    void* args[] = {&a};
    hipError_t e = hipLaunchCooperativeKernel((const void*)hymba_fwd, dim3(grid), dim3(NWAVES * 64), args, LDS_BYTES, stream);
    if (e != hipSuccess) fprintf(stderr, "cooperative launch failed: %s (grid %d)\n", hipGetErrorString(e), grid);
#else
    for (int ph = 0; ph < N_PHASES; ++ph) {
        a.ph_lo = ph; a.ph_hi = ph + 1;
        hipLaunchKernelGGL(hymba_fwd, dim3(grid), dim3(NWAVES * 64), LDS_BYTES, stream, a);
    }
#endif
}
```
